# Optimizing an MI355X kernel written in HIP

```python
import jax, jax.numpy as jnp
from jax import lax
import numpy as np

D_MODEL = 1024
BATCH = 4
SEQ = 4096
DEPTH = 4

N_META = 16
BLOCK = 128
PAD = (-N_META) % BLOCK
EPS = 1e-6
NEG_INF = -1e30

MLA_HEADS = 4
MLA_NOPE = 64
MLA_ROPE = 32
MLA_V = 64
MLA_Q_RANK = 256
MLA_KV_RANK = 128
ROPE_THETA = 10000.0

RW_HEADS = 4
RW_HEAD = 64
RW_W = RW_HEADS * RW_HEAD
RW_DECAY_LORA = 64
RW_A_LORA = 64
RW_G_LORA = 128
RW_GN_EPS = 64e-5
RW_IN = 3 * RW_W + RW_DECAY_LORA + RW_A_LORA + RW_G_LORA
RW_SPLITS = [RW_W, 2 * RW_W, 3 * RW_W, 3 * RW_W + RW_DECAY_LORA, 3 * RW_W + RW_DECAY_LORA + RW_A_LORA]

SB_HEADS = 4
SB_HEAD = 64
SB_W = SB_HEADS * SB_HEAD

GLA_HEADS = 4
GLA_DK = 32
GLA_DV = 64
GLA_GATE_LORA = 16
GLA_TAU = 16.0
GLA_QK = GLA_HEADS * GLA_DK
GLA_W = GLA_HEADS * GLA_DV
GLA_IN = 2 * GLA_QK + GLA_W + GLA_GATE_LORA + GLA_W
GLA_SPLITS = [GLA_QK, 2 * GLA_QK, 2 * GLA_QK + GLA_W, 2 * GLA_QK + GLA_W + GLA_GATE_LORA]

N_BRANCH = 4
BRANCH_W = 256
IN_SIZES = [MLA_Q_RANK, MLA_KV_RANK, MLA_ROPE, RW_IN, 3 * SB_W, GLA_IN, N_BRANCH * D_MODEL]
IN_SPLITS = [int(s) for s in np.cumsum(IN_SIZES)[:-1]]
IN_TOTAL = int(sum(IN_SIZES))

D_FF = 2816
CONV_W = 3

kernel_name = "hybrid_gated_merge_mla_rwkv7_stickbreak_gla_convffn"


def rmsnorm(x, g):
    xf = x.astype(jnp.float32)
    y = xf * lax.rsqrt(jnp.mean(xf * xf, axis=-1, keepdims=True) + EPS)
    return (y * g).astype(x.dtype)


def shift(t):
    return jnp.pad(t[:, :-1], ((0, 0), (1, 0), (0, 0)))


def pad_front(t):
    return jnp.pad(t, ((0, 0), (PAD, 0)) + ((0, 0),) * (t.ndim - 2))


def rope(x, pos):
    half = x.shape[-1] // 2
    freqs = ROPE_THETA ** (-jnp.arange(half, dtype=jnp.float32) / half)
    ang = pos.astype(jnp.float32)[:, None] * freqs[None, :]
    cos = jnp.cos(ang)[None, :, None, :]
    sin = jnp.sin(ang)[None, :, None, :]
    x1, x2 = x[..., :half], x[..., half:]
    return jnp.concatenate([x1 * cos - x2 * sin, x1 * sin + x2 * cos], axis=-1).astype(x.dtype)


def sweep_blocks(weights_fn, q, k, v):
    B, Lp, H, dk = q.shape
    nb = Lp // BLOCK
    scale = dk ** -0.5
    k_pos = jnp.arange(Lp)[None, :]
    qb = q.reshape(B, nb, BLOCK, H, dk).swapaxes(0, 1)

    def one(args):
        q_blk, i = args
        z = jnp.einsum('bqhd,bkhd->bhqk', q_blk, k).astype(jnp.float32) * scale
        q_pos = (i * BLOCK + jnp.arange(BLOCK))[:, None]
        w = weights_fn(z, q_pos, k_pos)
        return jnp.einsum('bhqk,bkhd->bqhd', w.astype(v.dtype), v)

    out = lax.map(one, (qb, jnp.arange(nb)))
    return out.swapaxes(0, 1).reshape(B, Lp, H, v.shape[-1])


def softmax_weights(z, q_pos, k_pos):
    mask = (k_pos <= q_pos) & (k_pos >= PAD)
    return jax.nn.softmax(jnp.where(mask, z, NEG_INF), axis=-1)


def stick_breaking_weights(z, q_pos, k_pos):
    mask = (k_pos < q_pos) & (k_pos >= PAD)
    log_keep = jnp.where(mask, jax.nn.log_sigmoid(-z), 0.0)
    log_later = lax.cumsum(log_keep, axis=3, reverse=True) - log_keep
    return jnp.where(mask, jnp.exp(jax.nn.log_sigmoid(z) + log_later), 0.0)


def gla_chunked(q, k, v, log_a):
    B, Lp, H, dk = q.shape
    dv = v.shape[-1]
    nc = Lp // BLOCK

    def chunks(t):
        return t.astype(jnp.float32).reshape(B, nc, BLOCK, H, t.shape[-1]).transpose(1, 0, 3, 2, 4)

    causal = jnp.tril(jnp.ones((BLOCK, BLOCK), dtype=bool))[:, :, None]

    def step(S, inp):
        qc, kc, vc, gc = inp
        b = jnp.cumsum(gc, axis=2)
        inter = jnp.einsum('bhik,bhkv->bhiv', qc * jnp.exp(b), S)
        rel = jnp.exp(jnp.where(causal, b[:, :, :, None, :] - b[:, :, None, :, :], NEG_INF))
        scores = jnp.einsum('bhik,bhisk->bhis', qc, rel * kc[:, :, None, :, :])
        intra = jnp.einsum('bhis,bhsv->bhiv', scores, vc)
        b_end = b[:, :, -1:, :]
        S = S * jnp.exp(b_end[:, :, 0, :, None]) + jnp.einsum('bhsk,bhsv->bhkv', kc * jnp.exp(b_end - b), vc)
        return S, inter + intra

    S0 = jnp.zeros((B, H, dk, dv), jnp.float32)
    _, o = lax.scan(step, S0, (chunks(q), chunks(k), chunks(v), chunks(log_a)))
    return o.transpose(1, 0, 3, 2, 4).reshape(B, Lp, H, dv).astype(v.dtype)


def mla_branch(cq, ckv, kr, pos, q_norm, w_uq, kv_norm, w_ukv):
    B, L, _ = cq.shape
    q = (rmsnorm(cq, q_norm) @ w_uq).reshape(B, L, MLA_HEADS, MLA_NOPE + MLA_ROPE)
    kv = (rmsnorm(ckv, kv_norm) @ w_ukv).reshape(B, L, MLA_HEADS, MLA_NOPE + MLA_V)
    k_rope = jnp.broadcast_to(rope(kr[:, :, None, :], pos), (B, L, MLA_HEADS, MLA_ROPE))
    q = jnp.concatenate([q[..., :MLA_NOPE], rope(q[..., MLA_NOPE:], pos)], axis=-1)
    k = jnp.concatenate([kv[..., :MLA_NOPE], k_rope], axis=-1)
    v = kv[..., MLA_NOPE:]
    o = sweep_blocks(softmax_weights, pad_front(q), pad_front(k), pad_front(v))[:, PAD:]
    return o.reshape(B, L, MLA_HEADS * MLA_V)


def rwkv7_branch(z_rw, mu, w0, w2, a0, a2, g2, k_k, k_a, r_k, ln_w, ln_b):
    B, L, _ = z_rw.shape
    z = z_rw + (shift(z_rw) - z_rw) * mu
    r, k, v, wl, al, gl = jnp.split(z, RW_SPLITS, axis=-1)
    w = -jax.nn.softplus(-(w0 + jnp.tanh(wl) @ w2)) - 0.5
    decay = jnp.exp(-jnp.exp(w.astype(jnp.float32)))
    a = jax.nn.sigmoid(a0 + al @ a2)
    g = jax.nn.sigmoid(gl) @ g2

    def heads(t):
        return t.astype(jnp.float32).reshape(B, L, RW_HEADS, RW_HEAD)

    kk = heads(k * k_k)
    kk = kk / jnp.maximum(jnp.linalg.norm(kk, axis=-1, keepdims=True), 1e-12)
    a = heads(a)
    k = heads(k) * (1.0 + (a - 1.0) * k_a.astype(jnp.float32).reshape(RW_HEADS, RW_HEAD))
    r, v, decay = heads(r), heads(v), heads(decay)

    def step(S, inp):
        r_t, w_t, k_t, v_t, kk_t, a_t = inp
        s_kk = jnp.einsum('bhvk,bhk->bhv', S, kk_t)
        S = S * w_t[:, :, None, :] - s_kk[..., None] * (kk_t * a_t)[:, :, None, :] + v_t[..., None] * k_t[:, :, None, :]
        return S, jnp.einsum('bhvk,bhk->bhv', S, r_t)

    tm = lambda t: t.swapaxes(0, 1)
    S0 = jnp.zeros((B, RW_HEADS, RW_HEAD, RW_HEAD), jnp.float32)
    _, y = lax.scan(step, S0, (tm(r), tm(decay), tm(k), tm(v), tm(kk), tm(a)))
    y = tm(y)
    mean = jnp.mean(y, axis=-1, keepdims=True)
    var = jnp.var(y, axis=-1, keepdims=True)
    y = (y - mean) * lax.rsqrt(var + RW_GN_EPS)
    y = y * ln_w.reshape(RW_HEADS, RW_HEAD) + ln_b.reshape(RW_HEADS, RW_HEAD)
    y = y + jnp.sum(r * k * r_k, axis=-1, keepdims=True) * v
    return (y.reshape(B, L, RW_W) * g).astype(z_rw.dtype)


def stick_breaking_branch(z_sb):
    B, L, _ = z_sb.shape
    q, k, v = [t.reshape(B, L, SB_HEADS, SB_HEAD) for t in jnp.split(z_sb, 3, axis=-1)]
    o = sweep_blocks(stick_breaking_weights, pad_front(q), pad_front(k), pad_front(v))[:, PAD:]
    return o.reshape(B, L, SB_W)


def gla_branch(z_gla, a2, a_b, norm_g):
    B, L, _ = z_gla.shape
    q, k, v, al, r = jnp.split(z_gla, GLA_SPLITS, axis=-1)
    q = q.reshape(B, L, GLA_HEADS, GLA_DK) * GLA_DK ** -0.5
    k = k.reshape(B, L, GLA_HEADS, GLA_DK)
    v = v.reshape(B, L, GLA_HEADS, GLA_DV)
    log_a = (jax.nn.log_sigmoid((al @ a2 + a_b).astype(jnp.float32)) / GLA_TAU).reshape(B, L, GLA_HEADS, GLA_DK)
    o = gla_chunked(pad_front(q), pad_front(k), pad_front(v), pad_front(log_a))[:, PAD:]
    o = rmsnorm(o, norm_g.reshape(GLA_HEADS, GLA_DV))
    return o.reshape(B, L, GLA_W) * jax.nn.silu(r)


def token_mixing(n, pos, w_in, mla_q_norm, mla_w_uq, mla_kv_norm, mla_w_ukv,
                 rw_mu, rw_w0, rw_w2, rw_a0, rw_a2, rw_g2, rw_k_k, rw_k_a, rw_r_k, rw_ln_w, rw_ln_b,
                 gla_a2, gla_a_b, gla_norm, gate_b, w_branch, w_out):
    B, L, _ = n.shape
    cq, ckv, kr, z_rw, z_sb, z_gla, gate_logits = jnp.split(n @ w_in, IN_SPLITS, axis=-1)
    y_mla = mla_branch(cq, ckv, kr, pos, mla_q_norm, mla_w_uq, mla_kv_norm, mla_w_ukv)
    y_rw = rwkv7_branch(z_rw, rw_mu, rw_w0, rw_w2, rw_a0, rw_a2, rw_g2, rw_k_k, rw_k_a, rw_r_k, rw_ln_w, rw_ln_b)
    y_sb = stick_breaking_branch(z_sb)
    y_gla = gla_branch(z_gla, gla_a2, gla_a_b, gla_norm)
    y = jnp.stack([y_mla, y_rw, y_sb, y_gla], axis=2)
    branch = jnp.einsum('blnc,ncd->blnd', y, w_branch)
    gates = jax.nn.sigmoid(gate_logits.reshape(B, L, N_BRANCH, D_MODEL) + gate_b)
    return jnp.sum(gates * branch, axis=2) @ w_out


def conv_ffn(n, w_ffn_in, conv_w, conv_b, w_ffn_out):
    L = n.shape[1]
    a, u = jnp.split(n @ w_ffn_in, 2, axis=-1)
    a_pad = jnp.pad(a, ((0, 0), (CONV_W - 1, 0), (0, 0)))
    a = conv_b + sum(a_pad[:, j:j + L] * conv_w[j] for j in range(CONV_W))
    return (jax.nn.silu(a) * u) @ w_ffn_out


def setup_inputs(seed: int = 0) -> dict:
    key = jax.random.key(seed)
    ks = iter(jax.random.split(key, 40))

    def nrm(shape, scale):
        return scale * jax.random.normal(next(ks), shape, jnp.float32)

    def gain(shape):
        return 1.0 + nrm(shape, 0.02)

    return {
        "x": nrm((BATCH, SEQ, D_MODEL), 1.0),
        "meta_tokens": nrm((N_META, D_MODEL), 1.0),
        "norm_mix": gain((DEPTH, D_MODEL)),
        "w_in": nrm((DEPTH, D_MODEL, IN_TOTAL), D_MODEL ** -0.5),
        "mla_q_norm": gain((DEPTH, MLA_Q_RANK)),
        "mla_w_uq": nrm((DEPTH, MLA_Q_RANK, MLA_HEADS * (MLA_NOPE + MLA_ROPE)), MLA_Q_RANK ** -0.5),
        "mla_kv_norm": gain((DEPTH, MLA_KV_RANK)),
        "mla_w_ukv": nrm((DEPTH, MLA_KV_RANK, MLA_HEADS * (MLA_NOPE + MLA_V)), MLA_KV_RANK ** -0.5),
        "rw_mu": jax.random.uniform(next(ks), (DEPTH, RW_IN), jnp.float32),
        "rw_w0": nrm((DEPTH, RW_W), 0.5),
        "rw_w2": nrm((DEPTH, RW_DECAY_LORA, RW_W), RW_DECAY_LORA ** -0.5),
        "rw_a0": nrm((DEPTH, RW_W), 0.1),
        "rw_a2": nrm((DEPTH, RW_A_LORA, RW_W), RW_A_LORA ** -0.5),
        "rw_g2": nrm((DEPTH, RW_G_LORA, RW_W), RW_G_LORA ** -0.5),
        "rw_k_k": 0.85 + nrm((DEPTH, RW_W), 0.02),
        "rw_k_a": 1.0 + nrm((DEPTH, RW_W), 0.02),
        "rw_r_k": nrm((DEPTH, RW_HEADS, RW_HEAD), 0.1),
        "rw_ln_w": gain((DEPTH, RW_W)),
        "rw_ln_b": nrm((DEPTH, RW_W), 0.02),
        "gla_a2": nrm((DEPTH, GLA_GATE_LORA, GLA_QK), GLA_GATE_LORA ** -0.5),
        "gla_a_b": nrm((DEPTH, GLA_QK), 0.1),
        "gla_norm": gain((DEPTH, GLA_W)),
        "gate_b": nrm((DEPTH, N_BRANCH, D_MODEL), 0.02),
        "w_branch": nrm((DEPTH, N_BRANCH, BRANCH_W, D_MODEL), BRANCH_W ** -0.5),
        "w_out": nrm((DEPTH, D_MODEL, D_MODEL), D_MODEL ** -0.5),
        "norm_ffn": gain((DEPTH, D_MODEL)),
        "w_ffn_in": nrm((DEPTH, D_MODEL, 2 * D_FF), D_MODEL ** -0.5),
        "ffn_conv_w": nrm((DEPTH, CONV_W, D_FF), CONV_W ** -0.5),
        "ffn_conv_b": nrm((DEPTH, D_FF), 0.02),
        "w_ffn_out": nrm((DEPTH, D_FF, D_MODEL), D_FF ** -0.5),
        "norm_final": gain((D_MODEL,)),
    }


def reference(x, meta_tokens, norm_mix, w_in, mla_q_norm, mla_w_uq, mla_kv_norm, mla_w_ukv,
              rw_mu, rw_w0, rw_w2, rw_a0, rw_a2, rw_g2, rw_k_k, rw_k_a, rw_r_k, rw_ln_w, rw_ln_b,
              gla_a2, gla_a_b, gla_norm, gate_b, w_branch, w_out,
              norm_ffn, w_ffn_in, ffn_conv_w, ffn_conv_b, w_ffn_out, norm_final):
    B = x.shape[0]
    meta = jnp.broadcast_to(meta_tokens[None].astype(x.dtype), (B, N_META, D_MODEL))
    h = jnp.concatenate([meta, x], axis=1)
    pos = jnp.arange(h.shape[1])
    for i in range(DEPTH):
        h = h + token_mixing(rmsnorm(h, norm_mix[i]), pos, w_in[i],
                             mla_q_norm[i], mla_w_uq[i], mla_kv_norm[i], mla_w_ukv[i],
                             rw_mu[i], rw_w0[i], rw_w2[i], rw_a0[i], rw_a2[i], rw_g2[i],
                             rw_k_k[i], rw_k_a[i], rw_r_k[i], rw_ln_w[i], rw_ln_b[i],
                             gla_a2[i], gla_a_b[i], gla_norm[i], gate_b[i], w_branch[i], w_out[i])
        h = h + conv_ffn(rmsnorm(h, norm_ffn[i]), w_ffn_in[i], ffn_conv_w[i], ffn_conv_b[i], w_ffn_out[i])
    return rmsnorm(h, norm_final)[:, N_META:]
```

```cpp
#include <hip/hip_runtime.h>
#include <hip/hip_cooperative_groups.h>
#include <stdint.h>
#include <stdio.h>
namespace cg = cooperative_groups;

#define DI __device__ __forceinline__
typedef unsigned short bf16_t;
typedef short bf16x8 __attribute__((ext_vector_type(8)));
typedef short s16x4 __attribute__((ext_vector_type(4)));
typedef float f32x16 __attribute__((ext_vector_type(16)));

constexpr int D = 1024, NBATCH = 4, SEQ = 4096, LTOK = 4112, PADF = 112, LP = 4224, M = NBATCH * LP;
constexpr int ZLD = 3072;
constexpr int ZC_CQ = 0, ZC_CKV = 256, ZC_KR = 384, ZC_RW = 416, ZC_SB = 1440, ZC_GLA = 2208;
constexpr int INTOT = 7088, GATE0 = 2992, DFF = 2816, MH = M / 2;

constexpr size_t al256(size_t x) { return (x + 255) & ~(size_t)255; }
constexpr size_t OFF_CTR = 0;
constexpr size_t OFF_H = 1024;
constexpr size_t OFF_NB = OFF_H + (size_t)M * D * 4;
constexpr size_t OFF_Y = OFF_NB + (size_t)M * D * 2;
constexpr size_t OFF_W = OFF_Y + (size_t)M * D * 2;
constexpr size_t W_WIN = 0;
constexpr size_t W_UQ = W_WIN + (size_t)INTOT * 1024 * 2;
constexpr size_t W_UKV = W_UQ + (size_t)384 * 256 * 2;
constexpr size_t W_BR = W_UKV + (size_t)512 * 128 * 2;
constexpr size_t W_OUT = W_BR + (size_t)4 * 1024 * 256 * 2;
constexpr size_t W_FIN = W_OUT + (size_t)1024 * 1024 * 2;
constexpr size_t W_FOUT = W_FIN + (size_t)5632 * 1024 * 2;
constexpr size_t W_END = W_FOUT + (size_t)1024 * DFF * 2;
constexpr size_t OFF_S = al256(OFF_W + W_END);
constexpr size_t S_Z = 0;
constexpr size_t S_CQN = S_Z + (size_t)M * ZLD * 2;
constexpr size_t S_CKVN = S_CQN + (size_t)M * 256 * 2;
constexpr size_t S_QM = S_CKVN + (size_t)M * 128 * 2;
constexpr size_t S_KM = S_QM + (size_t)M * 384 * 2;
constexpr size_t S_VTM = S_KM + (size_t)M * 384 * 2;
constexpr size_t S_VTS = S_VTM + (size_t)16 * 64 * LP * 2;
constexpr size_t S_RWA = S_VTS + (size_t)16 * 64 * LP * 2;
constexpr size_t S_RWB = S_RWA + (size_t)M * 256 * 4;
constexpr size_t S_RWG = S_RWB + (size_t)M * 1280 * 2;
constexpr size_t S_RWBON = S_RWG + (size_t)M * 256 * 2;
constexpr size_t S_GLA = S_RWBON + (size_t)M * 4 * 4;
constexpr size_t S_RWRAW = S_GLA + (size_t)M * 128 * 4;
constexpr size_t S_GLRAW = S_RWRAW + (size_t)M * 256 * 4;
constexpr size_t S_END = S_GLRAW + (size_t)M * 256 * 4;
constexpr size_t S_MERGED = S_RWB;
constexpr size_t S_AU = 0;
constexpr size_t S_ACT = S_AU + (size_t)MH * 5632 * 2;
constexpr size_t WS_NEED = OFF_S + S_END;

struct Params { const float* in[31]; float* out; char* ws; };
#ifndef PHMASK
#define PHMASK 0xffffffffu
#endif
#define PH(b) if constexpr ((PHMASK >> (b)) & 1u)

DI int otid() { int t = threadIdx.x; asm volatile("" : "+v"(t)); return t; }
DI int obid() { int t = blockIdx.x; asm volatile("" : "+s"(t)); return t; }
DI float bf2f(bf16_t v) { return __uint_as_float(((unsigned)v) << 16); }
DI bf16_t f2bf(float f) { unsigned u = __float_as_uint(f); u += 0x7fffu + ((u >> 16) & 1u); return (bf16_t)(u >> 16); }
DI unsigned pack2(float a, float b) { return (unsigned)f2bf(a) | ((unsigned)f2bf(b) << 16); }
DI float wsum(float x) { x += __shfl_xor(x, 32); x += __shfl_xor(x, 16); x += __shfl_xor(x, 8); x += __shfl_xor(x, 4); x += __shfl_xor(x, 2); x += __shfl_xor(x, 1); return x; }
template <int CTRL> DI float dppf(float x) { return __int_as_float(__builtin_amdgcn_update_dpp(0, __float_as_int(x), CTRL, 0xf, 0xf, true)); }
DI float red16(float x) { x += dppf<0xB1>(x); x += dppf<0x4E>(x); x += dppf<0x141>(x); x += dppf<0x140>(x); return x; }
DI float sigmoidf_(float x) { return 1.0f / (1.0f + __expf(-x)); }
DI float softplusf_(float x) { return fmaxf(x, 0.f) + __logf(1.0f + __expf(-fabsf(x))); }
DI float tanhf_(float x) { return 1.0f - 2.0f / (1.0f + __expf(2.0f * x)); }
DI void rope_sc(int tok, int i, float& s, float& c) {
    float fr = exp2f(-(float)i * (13.287712379549449f / 16.0f));
    float ang = (float)tok * fr;
    double rv = (double)ang * 0.15915494309189535;
    rv -= floor(rv);
    float f = (float)rv;
    s = __builtin_amdgcn_sinf(f); c = __builtin_amdgcn_cosf(f);
}
#define MFMA(a, b, c) __builtin_amdgcn_mfma_f32_32x32x16_bf16((a), (b), (c), 0, 0, 0)

template <int NT>
DI void gemm_tile(f32x16 (&acc)[2][NT], const bf16_t* __restrict__ A, int lda, const bf16_t* __restrict__ Bt, int ldb, int K, bf16_t* lds) {
    constexpr int BN = 64 * NT;
    bf16_t* As = lds;
    bf16_t* Bs = lds + 2 * 128 * 40;
    const int tid = otid(), lane = tid & 63, wave = tid >> 6, wm = wave >> 1, wn = wave & 1, r = lane & 31, hh = lane >> 5;
    uint4 ra[2], rb[NT];
    const int row0 = tid >> 2, kc = tid & 3;
    auto gload = [&](int k0) {
#pragma unroll
        for (int i = 0; i < 2; ++i) ra[i] = *(const uint4*)(A + (size_t)(row0 + 64 * i) * lda + k0 + kc * 8);
#pragma unroll
        for (int i = 0; i < NT; ++i) rb[i] = *(const uint4*)(Bt + (size_t)(row0 + 64 * i) * ldb + k0 + kc * 8);
    };
    auto lstore = [&](int buf) {
#pragma unroll
        for (int i = 0; i < 2; ++i) *(uint4*)(As + buf * 5120 + (row0 + 64 * i) * 40 + kc * 8) = ra[i];
#pragma unroll
        for (int i = 0; i < NT; ++i) *(uint4*)(Bs + buf * BN * 40 + (row0 + 64 * i) * 40 + kc * 8) = rb[i];
    };
    gload(0); lstore(0); __syncthreads();
    const int nk = K >> 5;
    for (int kt = 0; kt < nk; ++kt) {
        const int cur = kt & 1;
        if (kt + 1 < nk) gload((kt + 1) << 5);
#pragma unroll
        for (int s = 0; s < 2; ++s) {
            bf16x8 af[2], bfr[NT];
#pragma unroll
            for (int mt = 0; mt < 2; ++mt) af[mt] = *(const bf16x8*)(As + cur * 5120 + (wm * 64 + mt * 32 + r) * 40 + s * 16 + hh * 8);
#pragma unroll
            for (int nt = 0; nt < NT; ++nt) bfr[nt] = *(const bf16x8*)(Bs + cur * BN * 40 + (wn * 32 * NT + nt * 32 + r) * 40 + s * 16 + hh * 8);
#pragma unroll
            for (int mt = 0; mt < 2; ++mt)
#pragma unroll
                for (int nt = 0; nt < NT; ++nt) acc[mt][nt] = MFMA(af[mt], bfr[nt], acc[mt][nt]);
        }
        if (kt + 1 < nk) lstore(cur ^ 1);
        __syncthreads();
    }
}
template <int NT> DI void acc_zero(f32x16 (&acc)[2][NT]) {
#pragma unroll
    for (int a = 0; a < 2; ++a)
#pragma unroll
        for (int b = 0; b < NT; ++b)
#pragma unroll
            for (int i = 0; i < 16; ++i) acc[a][b][i] = 0.f;
}
template <int NT, class F> DI void epi_foreach(f32x16 (&acc)[2][NT], int m0, int n0, F f) {
    const int lane = otid() & 63, wave = otid() >> 6, wm = wave >> 1, wn = wave & 1, r = lane & 31, hh = lane >> 5;
#pragma unroll
    for (int mt = 0; mt < 2; ++mt)
#pragma unroll
        for (int nt = 0; nt < NT; ++nt)
#pragma unroll
            for (int i = 0; i < 16; ++i) f(m0 + wm * 64 + mt * 32 + (i & 3) + 8 * (i >> 2) + 4 * hh, n0 + wn * 32 * NT + nt * 32 + r, acc[mt][nt][i]);
}
template <int NT, class Epi>
DI void phase_gemm(const bf16_t* A, int lda, const bf16_t* Bt, int ldb, int Mrows, int N, int K, bf16_t* lds, int tile0, int tstride, Epi epi) {
    constexpr int BN = 64 * NT;
    const int nN = N / BN, nT = (Mrows / 128) * nN;
    for (int t = tile0; t < nT; t += tstride) {
        const int mt = t / nN, nt = t % nN;
        f32x16 acc[2][NT]; acc_zero<NT>(acc);
        gemm_tile<NT>(acc, A + (size_t)mt * 128 * lda, lda, Bt + (size_t)nt * BN * ldb, ldb, K, lds);
        epi_foreach<NT>(acc, mt * 128, nt * BN, epi);
    }
}

DI void convT(const float* __restrict__ W, int K, int N, bf16_t* __restrict__ Wt, int gtid, int gthreads) {
    const int K8 = K >> 3; const long total = (long)N * K8;
    for (long u = gtid; u < total; u += gthreads) {
        const int n = (int)(u % N), k8 = (int)(u / N);
        const float* src = W + (size_t)(k8 * 8) * N + n;
        float v[8];
#pragma unroll
        for (int j = 0; j < 8; ++j) v[j] = src[(size_t)j * N];
        uint4 o; o.x = pack2(v[0], v[1]); o.y = pack2(v[2], v[3]); o.z = pack2(v[4], v[5]); o.w = pack2(v[6], v[7]);
        *(uint4*)(Wt + (size_t)n * K + k8 * 8) = o;
    }
}

DI void phase_norm(int mode, const Params& p, float* h, const float* __restrict__ g, bf16_t* nb) {
    const int lane = otid() & 63, wv = otid() >> 6;
    for (int R = obid() * 4 + wv; R < M; R += gridDim.x * 4) {
        const int b = R / LP, pos = R % LP;
        const float* src = h + (size_t)R * D; bool zero = false;
        if (mode == 1) { if (pos < PADF) zero = true; else if (pos < 128) src = p.in[1] + (size_t)(pos - PADF) * D; else src = p.in[0] + ((size_t)b * SEQ + pos - 128) * D; }
        if (mode == 2 && pos < 128) continue;
        float4 v[4]; float ss = 0.f;
#pragma unroll
        for (int i = 0; i < 4; ++i) {
            v[i] = zero ? make_float4(0.f, 0.f, 0.f, 0.f) : *(const float4*)(src + i * 256 + lane * 4);
            ss += v[i].x * v[i].x + v[i].y * v[i].y + v[i].z * v[i].z + v[i].w * v[i].w;
        }
        ss = wsum(ss);
        const float rs = rsqrtf(ss * (1.0f / 1024.0f) + 1e-6f);
#pragma unroll
        for (int i = 0; i < 4; ++i) {
            const float4 gg = *(const float4*)(g + i * 256 + lane * 4);
            float4 o; o.x = v[i].x * rs * gg.x; o.y = v[i].y * rs * gg.y; o.z = v[i].z * rs * gg.z; o.w = v[i].w * rs * gg.w;
            if (mode == 2) *(float4*)(p.out + ((size_t)b * SEQ + pos - 128) * D + i * 256 + lane * 4) = o;
            else {
                if (mode == 1) *(float4*)(h + (size_t)R * D + i * 256 + lane * 4) = v[i];
                uint2 w; w.x = pack2(o.x, o.y); w.y = pack2(o.z, o.w);
                *(uint2*)(nb + (size_t)R * D + i * 256 + lane * 4) = w;
            }
        }
    }
}

struct LayerW {
    const float *q_norm, *kv_norm, *mu, *w0, *w2, *a0, *a2, *g2, *k_k, *k_a, *r_k, *ln_w, *ln_b, *gla_a2, *gla_a_b, *gla_norm, *gate_b, *conv_w, *conv_b;
};
constexpr int TB = 8;
DI void phase_prep(const LayerW& L, char* S, float* zin) {
    const bf16_t* Z = (const bf16_t*)(S + S_Z);
    bf16_t* cqn = (bf16_t*)(S + S_CQN); bf16_t* ckvn = (bf16_t*)(S + S_CKVN); bf16_t* Km = (bf16_t*)(S + S_KM);
    bf16_t* VTs = (bf16_t*)(S + S_VTS); float* rwA = (float*)(S + S_RWA); bf16_t* rwB = (bf16_t*)(S + S_RWB);
    bf16_t* rwG = (bf16_t*)(S + S_RWG); float* rwBon = (float*)(S + S_RWBON); float* glA = (float*)(S + S_GLA);
    const int tid = otid(), lane = tid & 63, wv = tid >> 6;
    for (int grp = obid(); grp < M / TB; grp += gridDim.x) {
        const int R0 = grp * TB, b = R0 / LP, pos0 = R0 % LP;
        {
            const int ch = 768 + tid; const float mu = L.mu[ch];
            for (int i = 0; i < TB; ++i) {
                const int R = R0 + i, tok = pos0 + i - PADF;
                const float zc = bf2f(Z[(size_t)R * ZLD + ZC_RW + ch]);
                const float zp = (tok > 0) ? bf2f(Z[(size_t)(R - 1) * ZLD + ZC_RW + ch]) : 0.f;
                const float zs = zc + (zp - zc) * mu;
                zin[i * 256 + tid] = tid < 64 ? tanhf_(zs) : (tid < 128 ? zs : sigmoidf_(zs));
            }
        }
        __syncthreads();
        float aw[TB], aa[TB], ag[TB];
#pragma unroll
        for (int i = 0; i < TB; ++i) { aw[i] = 0.f; aa[i] = 0.f; ag[i] = 0.f; }
        for (int j = 0; j < 64; j += 4) {
            float w2v[4], a2v[4];
#pragma unroll
            for (int q = 0; q < 4; ++q) { w2v[q] = L.w2[(j + q) * 256 + tid]; a2v[q] = L.a2[(j + q) * 256 + tid]; }
#pragma unroll
            for (int tk = 0; tk < TB; ++tk) {
                const float4 zw = *(const float4*)(zin + tk * 256 + j);
                const float4 za = *(const float4*)(zin + tk * 256 + 64 + j);
                aw[tk] += zw.x * w2v[0] + zw.y * w2v[1] + zw.z * w2v[2] + zw.w * w2v[3];
                aa[tk] += za.x * a2v[0] + za.y * a2v[1] + za.z * a2v[2] + za.w * a2v[3];
            }
        }
        for (int j = 0; j < 128; j += 4) {
            float g2v[4];
#pragma unroll
            for (int q = 0; q < 4; ++q) g2v[q] = L.g2[(j + q) * 256 + tid];
#pragma unroll
            for (int tk = 0; tk < TB; ++tk) {
                const float4 zg = *(const float4*)(zin + tk * 256 + 128 + j);
                ag[tk] += zg.x * g2v[0] + zg.y * g2v[1] + zg.z * g2v[2] + zg.w * g2v[3];
            }
        }
        {
            const float mur = L.mu[tid], muk = L.mu[256 + tid], muv = L.mu[512 + tid];
            const float w0 = L.w0[tid], a0 = L.a0[tid], kkc = L.k_k[tid], kac = L.k_a[tid], rkc = L.r_k[tid];
#pragma unroll
            for (int tk = 0; tk < TB; ++tk) {
                const int R = R0 + tk, tok = pos0 + tk - PADF;
                const bf16_t* zr = Z + (size_t)R * ZLD + ZC_RW;
                float rc = bf2f(zr[tid]), kcur = bf2f(zr[256 + tid]), vc = bf2f(zr[512 + tid]);
                float rp = 0.f, kp = 0.f, vp = 0.f;
                if (tok > 0) { const bf16_t* zq = zr - ZLD; rp = bf2f(zq[tid]); kp = bf2f(zq[256 + tid]); vp = bf2f(zq[512 + tid]); }
                const float r = rc + (rp - rc) * mur, k = kcur + (kp - kcur) * muk, v = vc + (vp - vc) * muv;
                const float wv_ = -softplusf_(-(w0 + aw[tk])) - 0.5f;
                const float decay = __expf(-__expf(wv_));
                const float a = sigmoidf_(a0 + aa[tk]);
                const float kkr = k * kkc;
                const float nrm = sqrtf(wsum(kkr * kkr));
                const float kk = kkr / fmaxf(nrm, 1e-12f);
                const float k2 = k * (1.0f + (a - 1.0f) * kac);
                const float bon = wsum(r * k2 * rkc);
                rwA[(size_t)R * 256 + tid] = decay;
                bf16_t* o = rwB + (size_t)R * 1280 + tid;
                o[0] = f2bf(r); o[256] = f2bf(k2); o[512] = f2bf(v); o[768] = f2bf(kk); o[1024] = f2bf(kk * a);
                rwG[(size_t)R * 256 + tid] = f2bf(ag[tk]);
                if (lane == 0) rwBon[(size_t)R * 4 + wv] = bon;
            }
        }
        for (int q = 0; q < TB / 4; ++q) {
            const int R = R0 + wv * (TB / 4) + q, tok = pos0 + wv * (TB / 4) + q - PADF;
            const bf16_t* zr = Z + (size_t)R * ZLD;
            {
                const uint2 raw = *(const uint2*)(zr + ZC_CQ + lane * 4);
                const float x0 = __uint_as_float(raw.x << 16), x1 = __uint_as_float(raw.x & 0xffff0000u), x2 = __uint_as_float(raw.y << 16), x3 = __uint_as_float(raw.y & 0xffff0000u);
                const float ss = wsum(x0 * x0 + x1 * x1 + x2 * x2 + x3 * x3);
                const float rs = rsqrtf(ss * (1.0f / 256.0f) + 1e-6f);
                const float4 gq = *(const float4*)(L.q_norm + lane * 4);
                uint2 w; w.x = pack2(x0 * rs * gq.x, x1 * rs * gq.y); w.y = pack2(x2 * rs * gq.z, x3 * rs * gq.w);
                *(uint2*)(cqn + (size_t)R * 256 + lane * 4) = w;
            }
            {
                const unsigned raw = *(const unsigned*)(zr + ZC_CKV + lane * 2);
                const float x0 = __uint_as_float(raw << 16), x1 = __uint_as_float(raw & 0xffff0000u);
                const float ss = wsum(x0 * x0 + x1 * x1);
                const float rs = rsqrtf(ss * (1.0f / 128.0f) + 1e-6f);
                *(unsigned*)(ckvn + (size_t)R * 128 + lane * 2) = pack2(x0 * rs * L.kv_norm[lane * 2], x1 * rs * L.kv_norm[lane * 2 + 1]);
            }
            if (lane < 16) {
                const float x1 = bf2f(zr[ZC_KR + lane]), x2 = bf2f(zr[ZC_KR + 16 + lane]);
                float sn, cs; rope_sc(tok, lane, sn, cs);
                const bf16_t o1 = f2bf(x1 * cs - x2 * sn), o2 = f2bf(x1 * sn + x2 * cs);
#pragma unroll
                for (int hd = 0; hd < 4; ++hd) { Km[(size_t)R * 384 + hd * 96 + 64 + lane] = o1; Km[(size_t)R * 384 + hd * 96 + 80 + lane] = o2; }
            }
        }
        for (int i = 0; i < TB / 2; ++i) {
            const int idx = tid + 256 * i, tk = idx >> 7, c = idx & 127, R = R0 + tk;
            const bf16_t* al = Z + (size_t)R * ZLD + ZC_GLA + 512;
            float x = L.gla_a_b[c];
#pragma unroll
            for (int j = 0; j < 16; ++j) x += bf2f(al[j]) * L.gla_a2[j * 128 + c];
            const float ls = fminf(x, 0.f) - __logf(1.0f + __expf(-fabsf(x)));
            glA[(size_t)R * 128 + c] = __expf(ls * (1.0f / 16.0f));
        }
        {
            unsigned pk[4];
#pragma unroll
            for (int tk = 0; tk < TB; tk += 2) {
                const unsigned lo = Z[(size_t)(R0 + tk) * ZLD + ZC_SB + 512 + tid], hi = Z[(size_t)(R0 + tk + 1) * ZLD + ZC_SB + 512 + tid];
                pk[tk >> 1] = lo | (hi << 16);
            }
            bf16_t* dst = VTs + ((size_t)((b * 4 + (tid >> 6)) * 64 + (tid & 63))) * LP + pos0;
            *(uint4*)dst = make_uint4(pk[0], pk[1], pk[2], pk[3]);
        }
        __syncthreads();
    }
}

template <bool SB>
DI void attn_item(int bh, int qblk, const bf16_t* __restrict__ Qb, const bf16_t* __restrict__ Kb, int stride, const bf16_t* __restrict__ VT, bf16_t* __restrict__ y, int ycol0) {
    constexpr int KS = SB ? 4 : 6, HD = SB ? 64 : 96;
    const float scale = SB ? 0.125f : 0.10206207261596575f;
    const int lane = otid() & 63, wave = otid() >> 6, r = lane & 31, hh = lane >> 5;
    const int b = bh >> 2, h = bh & 3;
    const int qb32 = qblk * 4 + wave, qpos = qb32 * 32 + r;
    const bf16_t* Qrow = Qb + (size_t)(b * LP + qpos) * stride + h * HD;
    bf16x8 qf[KS];
#pragma unroll
    for (int s = 0; s < KS; ++s) qf[s] = *(const bf16x8*)(Qrow + 16 * s + 8 * hh);
    if (!SB) {
#pragma unroll
        for (int j = 0; j < 8; ++j) {
            float sn, cs; rope_sc(qpos - PADF, 8 * hh + j, sn, cs);
            const float x1 = bf2f((bf16_t)qf[KS - 2][j]), x2 = bf2f((bf16_t)qf[KS - 1][j]);
            qf[KS - 2][j] = (short)f2bf(x1 * cs - x2 * sn); qf[KS - 1][j] = (short)f2bf(x1 * sn + x2 * cs);
        }
    }
    const bf16_t* Kbase = Kb + (size_t)(b * LP) * stride + h * HD;
    const bf16_t* VTb = VT + (size_t)(bh * 64) * LP;
    f32x16 O[2];
#pragma unroll
    for (int i = 0; i < 16; ++i) { O[0][i] = 0.f; O[1][i] = 0.f; }
    float mrun = -1e30f, lrun = 0.f, Lc = 0.f;
    for (int kb = qb32; kb >= 3; --kb) {
        const int kpos0 = kb * 32;
        bf16x8 kf[KS];
#pragma unroll
        for (int s = 0; s < KS; ++s) kf[s] = *(const bf16x8*)(Kbase + (size_t)(kpos0 + r) * stride + 16 * s + 8 * hh);
        bf16x8 vf[2][2];
#pragma unroll
        for (int mt = 0; mt < 2; ++mt)
#pragma unroll
            for (int s2 = 0; s2 < 2; ++s2) {
                const bf16_t* vp = VTb + (size_t)(mt * 32 + r) * LP + kpos0 + 16 * s2 + 4 * hh;
                const s16x4 lo = *(const s16x4*)vp, hi = *(const s16x4*)(vp + 8);
                vf[mt][s2] = __builtin_shufflevector(lo, hi, 0, 1, 2, 3, 4, 5, 6, 7);
            }
        f32x16 Sx;
#pragma unroll
        for (int i = 0; i < 16; ++i) Sx[i] = 0.f;
#pragma unroll
        for (int s = 0; s < KS; ++s) Sx = MFMA(kf[s], qf[s], Sx);
        const bool edge = (kb == qb32) || (kb == 3);
        float pv[16];
        if (!SB) {
            float zmax = -1e30f;
#pragma unroll
            for (int i = 0; i < 16; ++i) {
                float z = Sx[i] * scale;
                if (edge) { const int key = kpos0 + (i & 3) + 8 * (i >> 2) + 4 * hh; z = (key >= PADF && key <= qpos) ? z : -1e30f; }
                Sx[i] = z; zmax = fmaxf(zmax, z);
            }
            zmax = fmaxf(zmax, __shfl_xor(zmax, 32));
            const float mnew = fmaxf(mrun, zmax), alpha = __expf(mrun - mnew);
            float ps = 0.f;
#pragma unroll
            for (int i = 0; i < 16; ++i) { pv[i] = __expf(Sx[i] - mnew); ps += pv[i]; }
            lrun = lrun * alpha + ps; mrun = mnew;
#pragma unroll
            for (int i = 0; i < 16; ++i) { O[0][i] *= alpha; O[1][i] *= alpha; }
        } else {
            float lk[16], ls[16]; unsigned okm = 0;
#pragma unroll
            for (int i = 0; i < 16; ++i) {
                const float z = Sx[i] * scale, sp = softplusf_(z);
                bool ok = true;
                if (edge) { const int key = kpos0 + (i & 3) + 8 * (i >> 2) + 4 * hh; ok = (key >= PADF && key < qpos); }
                lk[i] = ok ? -sp : 0.f; ls[i] = z - sp; okm |= (ok ? 1u : 0u) << i;
            }
            float gs[4], pg[4];
#pragma unroll
            for (int q = 0; q < 4; ++q) { gs[q] = (lk[4 * q] + lk[4 * q + 1]) + (lk[4 * q + 2] + lk[4 * q + 3]); pg[q] = __shfl_xor(gs[q], 32); }
            float T[4]; float run = 0.f;
#pragma unroll
            for (int q = 3; q >= 0; --q) { T[q] = run + (hh == 0 ? pg[q] : 0.f); run += gs[q] + pg[q]; }
#pragma unroll
            for (int q = 0; q < 4; ++q) {
                float wsuf = 0.f;
#pragma unroll
                for (int e = 3; e >= 0; --e) {
                    const int i = 4 * q + e;
                    const float later = Lc + T[q] + wsuf;
                    pv[i] = ((okm >> i) & 1u) ? __expf(ls[i] + later) : 0.f;
                    wsuf += lk[i];
                }
            }
            Lc += run;
        }
        bf16x8 pb[2];
#pragma unroll
        for (int s2 = 0; s2 < 2; ++s2) {
            uint4 w; w.x = pack2(pv[8 * s2], pv[8 * s2 + 1]); w.y = pack2(pv[8 * s2 + 2], pv[8 * s2 + 3]); w.z = pack2(pv[8 * s2 + 4], pv[8 * s2 + 5]); w.w = pack2(pv[8 * s2 + 6], pv[8 * s2 + 7]);
            pb[s2] = __builtin_bit_cast(bf16x8, w);
        }
#pragma unroll
        for (int mt = 0; mt < 2; ++mt)
#pragma unroll
            for (int s2 = 0; s2 < 2; ++s2) O[mt] = MFMA(vf[mt][s2], pb[s2], O[mt]);
    }
    float inv = 1.0f;
    if (!SB) { const float lt = lrun + __shfl_xor(lrun, 32); inv = 1.0f / lt; }
    bf16_t* yrow = y + (size_t)(b * LP + qpos) * 1024 + ycol0 + h * 64;
#pragma unroll
    for (int mt = 0; mt < 2; ++mt)
#pragma unroll
        for (int g = 0; g < 4; ++g) {
            uint2 w; w.x = pack2(O[mt][4 * g] * inv, O[mt][4 * g + 1] * inv); w.y = pack2(O[mt][4 * g + 2] * inv, O[mt][4 * g + 3] * inv);
            *(uint2*)(yrow + mt * 32 + 8 * g + 4 * hh) = w;
        }
}

DI void rwkv_item(int item, char* S, float* lds) {
    const float* rwA = (const float*)(S + S_RWA); const bf16_t* rwB = (const bf16_t*)(S + S_RWB); float* raw = (float*)(S + S_RWRAW);
    const int bh = item >> 2, rg = item & 3, b = bh >> 2, h = bh & 3;
    const int tid = otid(), lane = tid & 63, wave = tid >> 6, part = lane & 15, rowl = wave * 4 + (lane >> 4);
    float* vecb = lds;
    float* vb = lds + 2 * 5120;
    const size_t Rb = (size_t)b * LP + PADF;
    float4 st[5]; float sv;
    auto gload = [&](int c) {
#pragma unroll
        for (int i = 0; i < 5; ++i) {
            const int idx = tid + 256 * i, step = idx / 80, rem = idx % 80, vec = rem >> 4, c4 = rem & 15;
            const size_t R = Rb + c * 16 + step;
            if (vec == 1) st[i] = *(const float4*)(rwA + R * 256 + h * 64 + c4 * 4);
            else {
                const int plane = vec == 0 ? 3 : (vec == 2 ? 4 : (vec == 3 ? 1 : 0));
                const uint2 raw2 = *(const uint2*)(rwB + R * 1280 + plane * 256 + h * 64 + c4 * 4);
                st[i] = make_float4(__uint_as_float(raw2.x << 16), __uint_as_float(raw2.x & 0xffff0000u), __uint_as_float(raw2.y << 16), __uint_as_float(raw2.y & 0xffff0000u));
            }
        }
        { const int step = tid >> 4, row = tid & 15; sv = bf2f(rwB[(Rb + c * 16 + step) * 1280 + 512 + h * 64 + rg * 16 + row]); }
    };
    auto lstore = [&](int buf) {
#pragma unroll
        for (int i = 0; i < 5; ++i) {
            const int idx = tid + 256 * i, step = idx / 80, rem = idx % 80, vec = rem >> 4, c4 = rem & 15;
            *(float4*)(vecb + buf * 5120 + step * 320 + vec * 64 + c4 * 4) = st[i];
        }
        vb[buf * 256 + tid] = sv;
    };
    gload(0); lstore(0); __syncthreads();
    float4 Sx = make_float4(0.f, 0.f, 0.f, 0.f);
    constexpr int NC = LTOK / 16;
    for (int c = 0; c < NC; ++c) {
        const int cur = c & 1;
        if (c + 1 < NC) gload(c + 1);
        const float* vbp = vecb + cur * 5120 + part * 4;
#pragma unroll 4
        for (int s = 0; s < 16; ++s) {
            const float4 kk = *(const float4*)(vbp + s * 320), w = *(const float4*)(vbp + s * 320 + 64), kka = *(const float4*)(vbp + s * 320 + 128);
            const float4 k = *(const float4*)(vbp + s * 320 + 192), rr = *(const float4*)(vbp + s * 320 + 256);
            const float vv = vb[cur * 256 + s * 16 + rowl];
            float sa = (Sx.x * kk.x + Sx.y * kk.y) + (Sx.z * kk.z + Sx.w * kk.w);
            sa = red16(sa);
            Sx.x = Sx.x * w.x + (vv * k.x - sa * kka.x);
            Sx.y = Sx.y * w.y + (vv * k.y - sa * kka.y);
            Sx.z = Sx.z * w.z + (vv * k.z - sa * kka.z);
            Sx.w = Sx.w * w.w + (vv * k.w - sa * kka.w);
            float yy = (Sx.x * rr.x + Sx.y * rr.y) + (Sx.z * rr.z + Sx.w * rr.w);
            yy = red16(yy);
            if (part == 0) raw[(Rb + c * 16 + s) * 256 + h * 64 + rg * 16 + rowl] = yy;
        }
        if (c + 1 < NC) lstore(cur ^ 1);
        __syncthreads();
    }
}

DI void gla_item(int item, char* S, float* lds) {
    const float* glA = (const float*)(S + S_GLA); const bf16_t* Z = (const bf16_t*)(S + S_Z); float* raw = (float*)(S + S_GLRAW);
    const int bh = item >> 2, rg = item & 3, b = bh >> 2, h = bh & 3;
    const int tid = otid(), lane = tid & 63, wave = tid >> 6, part = lane & 15, rowl = wave * 4 + (lane >> 4);
    float* vecb = lds;
    float* vb = lds + 2 * 1536;
    const size_t Rb = (size_t)b * LP + PADF;
    float4 st[2]; float sv;
    auto gload = [&](int c) {
#pragma unroll
        for (int i = 0; i < 2; ++i) {
            const int idx = tid + 256 * i;
            if (idx < 384) {
                const int step = idx / 24, rem = idx % 24, vec = rem >> 3, c4 = rem & 7;
                const size_t R = Rb + c * 16 + step;
                if (vec == 0) st[i] = *(const float4*)(glA + R * 128 + h * 32 + c4 * 4);
                else {
                    const uint2 raw2 = *(const uint2*)(Z + R * ZLD + ZC_GLA + (vec == 1 ? 128 : 0) + h * 32 + c4 * 4);
                    st[i] = make_float4(__uint_as_float(raw2.x << 16), __uint_as_float(raw2.x & 0xffff0000u), __uint_as_float(raw2.y << 16), __uint_as_float(raw2.y & 0xffff0000u));
                }
            }
        }
        { const int step = tid >> 4, row = tid & 15; sv = bf2f(Z[(Rb + c * 16 + step) * ZLD + ZC_GLA + 256 + h * 64 + rg * 16 + row]); }
    };
    auto lstore = [&](int buf) {
#pragma unroll
        for (int i = 0; i < 2; ++i) {
            const int idx = tid + 256 * i;
            if (idx < 384) { const int step = idx / 24, rem = idx % 24, vec = rem >> 3, c4 = rem & 7; *(float4*)(vecb + buf * 1536 + step * 96 + vec * 32 + c4 * 4) = st[i]; }
        }
        vb[buf * 256 + tid] = sv;
    };
    gload(0); lstore(0); __syncthreads();
    float s0 = 0.f, s1 = 0.f;
    constexpr int NC = LTOK / 16;
    for (int c = 0; c < NC; ++c) {
        const int cur = c & 1;
        if (c + 1 < NC) gload(c + 1);
        const float* vbp = vecb + cur * 1536 + part * 2;
#pragma unroll 4
        for (int s = 0; s < 16; ++s) {
            const float2 a = *(const float2*)(vbp + s * 96), k = *(const float2*)(vbp + s * 96 + 32), q = *(const float2*)(vbp + s * 96 + 64);
            const float vv = vb[cur * 256 + s * 16 + rowl];
            s0 = a.x * s0 + k.x * vv; s1 = a.y * s1 + k.y * vv;
            float o = red16(q.x * s0 + q.y * s1);
            if (part == 0) raw[(Rb + c * 16 + s) * 256 + h * 64 + rg * 16 + rowl] = o;
        }
        if (c + 1 < NC) lstore(cur ^ 1);
        __syncthreads();
    }
}

__global__ void __launch_bounds__(256, 2) mega(Params p) {
    cg::grid_group grid = cg::this_grid();
    __shared__ __attribute__((aligned(16))) char smem[45056];
    __shared__ int s_item;
    bf16_t* ldsb = (bf16_t*)smem; float* ldsf = (float*)smem;
    char* ws = p.ws;
    unsigned* ctr = (unsigned*)(ws + OFF_CTR);
    float* h = (float*)(ws + OFF_H); bf16_t* nb = (bf16_t*)(ws + OFF_NB); bf16_t* y = (bf16_t*)(ws + OFF_Y);
    char* Wb = ws + OFF_W; char* S = ws + OFF_S;
    bf16_t* winT = (bf16_t*)(Wb + W_WIN); bf16_t* uqT = (bf16_t*)(Wb + W_UQ); bf16_t* ukvT = (bf16_t*)(Wb + W_UKV); bf16_t* brT = (bf16_t*)(Wb + W_BR);
    bf16_t* woutT = (bf16_t*)(Wb + W_OUT); bf16_t* finT = (bf16_t*)(Wb + W_FIN); bf16_t* foutT = (bf16_t*)(Wb + W_FOUT);
    bf16_t* Z = (bf16_t*)(S + S_Z); bf16_t* cqn = (bf16_t*)(S + S_CQN); bf16_t* ckvn = (bf16_t*)(S + S_CKVN); bf16_t* Qm = (bf16_t*)(S + S_QM); bf16_t* Km = (bf16_t*)(S + S_KM);
    bf16_t* VTm = (bf16_t*)(S + S_VTM); bf16_t* VTs = (bf16_t*)(S + S_VTS); bf16_t* merged = (bf16_t*)(S + S_MERGED);
    bf16_t* au = (bf16_t*)(S + S_AU); bf16_t* act = (bf16_t*)(S + S_ACT);
    const int gthreads = gridDim.x * 256;

    for (int layer = 0; layer < 4; ++layer) {
        LayerW L;
        L.q_norm = p.in[4] + layer * 256; L.kv_norm = p.in[6] + layer * 128; L.mu = p.in[8] + layer * 1024; L.w0 = p.in[9] + layer * 256;
        L.w2 = p.in[10] + layer * 64 * 256; L.a0 = p.in[11] + layer * 256; L.a2 = p.in[12] + layer * 64 * 256; L.g2 = p.in[13] + layer * 128 * 256;
        L.k_k = p.in[14] + layer * 256; L.k_a = p.in[15] + layer * 256; L.r_k = p.in[16] + layer * 256; L.ln_w = p.in[17] + layer * 256; L.ln_b = p.in[18] + layer * 256;
        L.gla_a2 = p.in[19] + layer * 16 * 128; L.gla_a_b = p.in[20] + layer * 128; L.gla_norm = p.in[21] + layer * 256; L.gate_b = p.in[22] + layer * 4096;
        L.conv_w = p.in[27] + layer * 3 * DFF; L.conv_b = p.in[28] + layer * DFF;

        { const int tid = otid(), gtid = obid() * 256 + tid; (void)tid;
        PH(0) {
        convT(p.in[3] + (size_t)layer * 1024 * INTOT, 1024, INTOT, winT, gtid, gthreads);
        convT(p.in[5] + (size_t)layer * 256 * 384, 256, 384, uqT, gtid, gthreads);
        convT(p.in[7] + (size_t)layer * 128 * 512, 128, 512, ukvT, gtid, gthreads);
        for (int n = 0; n < 4; ++n) convT(p.in[23] + ((size_t)layer * 4 + n) * 256 * 1024, 256, 1024, brT + (size_t)n * 1024 * 256, gtid, gthreads);
        convT(p.in[24] + (size_t)layer * 1024 * 1024, 1024, 1024, woutT, gtid, gthreads);
        convT(p.in[26] + (size_t)layer * 1024 * 5632, 1024, 5632, finT, gtid, gthreads);
        convT(p.in[29] + (size_t)layer * DFF * 1024, DFF, 1024, foutT, gtid, gthreads);
        phase_norm(layer == 0 ? 1 : 0, p, h, p.in[2] + layer * 1024, nb);
        }
        }
        grid.sync();

        PH(1) phase_gemm<2>(nb, 1024, winT, 1024, M, ZLD, 1024, ldsb, obid(), gridDim.x,
                      [&](int row, int col, float v) { Z[(size_t)row * ZLD + col] = f2bf(v); });
        grid.sync();

        PH(2) phase_prep(L, S, ldsf);
        grid.sync();

        PH(3) phase_gemm<2>(cqn, 256, uqT, 256, M, 384, 256, ldsb, obid(), gridDim.x,
                      [&](int row, int col, float v) { Qm[(size_t)row * 384 + col] = f2bf(v); });
        PH(4) phase_gemm<2>(ckvn, 128, ukvT, 128, M, 512, 128, ldsb, (obid() + gridDim.x / 2) % gridDim.x, gridDim.x,
                      [&](int row, int col, float v) {
                          const int hd = col >> 7, c = col & 127;
                          if (c < 64) Km[(size_t)row * 384 + hd * 96 + c] = f2bf(v);
                          else { const int b = row / LP, pos = row % LP; VTm[((size_t)((b * 4 + hd) * 64 + (c - 64))) * LP + pos] = f2bf(v); }
                      });
        grid.sync();

        for (;;) {
            const int tid = otid();
            if (tid == 0) s_item = (int)atomicAdd(ctr + layer, 1u);
            __syncthreads();
            const int item = s_item;
            __syncthreads();
            if (item >= 128 + 33 * 32) break;
            if (item < 64) { PH(5) rwkv_item(item, S, ldsf); }
            else if (item < 128) { PH(6) gla_item(item - 64, S, ldsf); }
            else {
                const int a = item - 128, qblk = 32 - a / 32, rem = a % 32, bh = rem & 15;
                if (rem < 16) { PH(7) attn_item<false>(bh, qblk, Qm, Km, 384, VTm, y, 0); }
                else { PH(8) attn_item<true>(bh, qblk, Z + ZC_SB, Z + ZC_SB + 256, ZLD, VTs, y, 512); }
            }
        }
        grid.sync();

        PH(9) {
            const float* rwRaw = (const float*)(S + S_RWRAW); const float* glRaw = (const float*)(S + S_GLRAW);
            const bf16_t* rwB = (const bf16_t*)(S + S_RWB); const bf16_t* rwG = (const bf16_t*)(S + S_RWG); const float* rwBon = (const float*)(S + S_RWBON);
            const int tid = otid();
            const float lnw = L.ln_w[tid], lnb = L.ln_b[tid], gn = L.gla_norm[tid];
            for (int R = obid(); R < M; R += gridDim.x) {
                if (R % LP < PADF) continue;
                {
                    const float yv = rwRaw[(size_t)R * 256 + tid];
                    const float mean = wsum(yv) * (1.0f / 64.0f), d = yv - mean;
                    const float var = wsum(d * d) * (1.0f / 64.0f);
                    float yn = d * rsqrtf(var + 64e-5f) * lnw + lnb;
                    yn += rwBon[(size_t)R * 4 + (tid >> 6)] * bf2f(rwB[(size_t)R * 1280 + 512 + tid]);
                    y[(size_t)R * 1024 + 256 + tid] = f2bf(yn * bf2f(rwG[(size_t)R * 256 + tid]));
                }
                {
                    const float o = glRaw[(size_t)R * 256 + tid] * 0.17677669529663687f;
                    const float ms = wsum(o * o) * (1.0f / 64.0f);
                    const float on = o * rsqrtf(ms + 1e-6f) * gn;
                    const float rgv = bf2f(Z[(size_t)R * ZLD + ZC_GLA + 528 + tid]);
                    y[(size_t)R * 1024 + 768 + tid] = f2bf(on * rgv * sigmoidf_(rgv));
                }
            }
        }
        grid.sync();

        PH(10) {
            const int nT = (M / 128) * 16; const int tid = otid();
            for (int t = obid(); t < nT; t += gridDim.x) {
                const int mt = t >> 4, nt = t & 15, m0 = mt * 128, n0 = nt * 64;
                f32x16 out[2][1]; acc_zero<1>(out);
                for (int n = 0; n < 4; ++n) {
                    f32x16 ag[2][1], ab[2][1]; acc_zero<1>(ag); acc_zero<1>(ab);
                    gemm_tile<1>(ag, nb + (size_t)m0 * 1024, 1024, winT + (size_t)(GATE0 + n * 1024 + n0) * 1024, 1024, 1024, ldsb);
                    gemm_tile<1>(ab, y + (size_t)m0 * 1024 + n * 256, 1024, brT + (size_t)(n * 1024 + n0) * 256, 256, 256, ldsb);
                    const int wave = tid >> 6, wn = wave & 1, r = tid & 31;
                    const float gb = L.gate_b[n * 1024 + n0 + wn * 32 + r];
#pragma unroll
                    for (int a = 0; a < 2; ++a)
#pragma unroll
                        for (int i = 0; i < 16; ++i) out[a][0][i] += sigmoidf_(ag[a][0][i] + gb) * ab[a][0][i];
                }
                epi_foreach<1>(out, m0, n0, [&](int row, int col, float v) { merged[(size_t)row * 1024 + col] = f2bf(v); });
            }
        }
        grid.sync();

        PH(11) phase_gemm<1>(merged, 1024, woutT, 1024, M, 1024, 1024, ldsb, obid(), gridDim.x,
                      [&](int row, int col, float v) { if (row % LP >= PADF) h[(size_t)row * D + col] += v; });
        grid.sync();

        PH(12) phase_norm(0, p, h, p.in[25] + layer * 1024, nb);
        grid.sync();

        for (int hf = 0; hf < 2; ++hf) {
            PH(13) phase_gemm<2>(nb + (size_t)hf * MH * 1024, 1024, finT, 1024, MH, 5632, 1024, ldsb, obid(), gridDim.x,
                          [&](int row, int col, float v) { au[(size_t)row * 5632 + col] = f2bf(v); });
            grid.sync();
            PH(14) {
                const long total = (long)MH * (DFF / 4); const int gtid = obid() * 256 + otid();
                for (long u = gtid; u < total; u += gthreads) {
                    const int rl = (int)(u / (DFF / 4)), f = (int)(u % (DFF / 4)) * 4;
                    const int tok = (hf * MH + rl) % LP - PADF;
                    const bf16_t* a2p = au + (size_t)rl * 5632 + f;
                    float out4[4];
                    const float4 cb = *(const float4*)(L.conv_b + f), w0 = *(const float4*)(L.conv_w + f), w1 = *(const float4*)(L.conv_w + DFF + f), w2 = *(const float4*)(L.conv_w + 2 * DFF + f);
                    const float cbv[4] = {cb.x, cb.y, cb.z, cb.w}, w0v[4] = {w0.x, w0.y, w0.z, w0.w}, w1v[4] = {w1.x, w1.y, w1.z, w1.w}, w2v[4] = {w2.x, w2.y, w2.z, w2.w};
                    const uint2 c0 = *(const uint2*)a2p, uu = *(const uint2*)(a2p + DFF);
                    uint2 c1 = make_uint2(0u, 0u), c2 = make_uint2(0u, 0u);
                    if (tok >= 1) c1 = *(const uint2*)(a2p - 5632);
                    if (tok >= 2) c2 = *(const uint2*)(a2p - 2 * 5632);
                    const float a0v[4] = {__uint_as_float(c0.x << 16), __uint_as_float(c0.x & 0xffff0000u), __uint_as_float(c0.y << 16), __uint_as_float(c0.y & 0xffff0000u)};
                    const float a1v[4] = {__uint_as_float(c1.x << 16), __uint_as_float(c1.x & 0xffff0000u), __uint_as_float(c1.y << 16), __uint_as_float(c1.y & 0xffff0000u)};
                    const float a2v[4] = {__uint_as_float(c2.x << 16), __uint_as_float(c2.x & 0xffff0000u), __uint_as_float(c2.y << 16), __uint_as_float(c2.y & 0xffff0000u)};
                    const float uv[4] = {__uint_as_float(uu.x << 16), __uint_as_float(uu.x & 0xffff0000u), __uint_as_float(uu.y << 16), __uint_as_float(uu.y & 0xffff0000u)};
#pragma unroll
                    for (int e = 0; e < 4; ++e) { const float a = cbv[e] + w0v[e] * a2v[e] + w1v[e] * a1v[e] + w2v[e] * a0v[e]; out4[e] = a * sigmoidf_(a) * uv[e]; }
                    uint2 w; w.x = pack2(out4[0], out4[1]); w.y = pack2(out4[2], out4[3]);
                    *(uint2*)(act + (size_t)rl * DFF + f) = w;
                }
            }
            grid.sync();
            PH(15) phase_gemm<1>(act, DFF, foutT, DFF, MH, 1024, DFF, ldsb, obid(), gridDim.x,
                          [&](int row, int col, float v) { const int R = hf * MH + row; if (R % LP >= PADF) h[(size_t)R * D + col] += v; });
            grid.sync();
        }
    }
    PH(16) phase_norm(2, p, h, p.in[30], nb);
}

extern "C" void kernel_launch(void* const* d_in, const int* in_sizes, int n_in, void* d_out, int out_size, void* d_ws, size_t ws_size, hipStream_t stream) {
    static int grid_blocks = 0;
    if (!grid_blocks) {
        int dev = 0, cus = 0, per_cu = 0;
        hipGetDevice(&dev);
        hipDeviceGetAttribute(&cus, hipDeviceAttributeMultiprocessorCount, dev);
        hipOccupancyMaxActiveBlocksPerMultiprocessor(&per_cu, mega, 256, 0);
        if (per_cu > 2) per_cu = 2;
        if (per_cu < 1) per_cu = 1;
        grid_blocks = cus * per_cu;
    }
    if (ws_size < WS_NEED) fprintf(stderr, "workspace too small: %zu < %zu\n", ws_size, (size_t)WS_NEED);
    Params p{};
    for (int i = 0; i < 31; ++i) p.in[i] = (const float*)d_in[i];
    p.out = (float*)d_out; p.ws = (char*)d_ws;
    hipMemsetAsync(d_ws, 0, 1024, stream);
    void* args[] = {&p};
    hipError_t e = hipLaunchCooperativeKernel((void*)mega, dim3(grid_blocks), dim3(256), args, 0, stream);
    if (e != hipSuccess) fprintf(stderr, "cooperative launch failed: %s (grid %d)\n", hipGetErrorString(e), grid_blocks);
}
```

```cpp
#include <hip/hip_runtime.h>
#include <hip/hip_cooperative_groups.h>
#include <stdint.h>
#include <stdio.h>
namespace cg = cooperative_groups;

#define DI __device__ __forceinline__
typedef unsigned short bf16_t;
typedef short bf16x8 __attribute__((ext_vector_type(8)));
typedef short s16x4 __attribute__((ext_vector_type(4)));
typedef float f32x16 __attribute__((ext_vector_type(16)));

constexpr int D = 1024, NBATCH = 4, SEQ = 4096, LTOK = 4112, PADF = 112, LP = 4224, M = NBATCH * LP;
constexpr int ZLD = 3072;
constexpr int ZC_CQ = 0, ZC_CKV = 256, ZC_KR = 384, ZC_RW = 416, ZC_SB = 1440, ZC_GLA = 2208;
constexpr int INTOT = 7088, GATE0 = 2992, DFF = 2816, MH = M / 2;

constexpr size_t al256(size_t x) { return (x + 255) & ~(size_t)255; }
constexpr size_t OFF_CTR = 0;
constexpr size_t OFF_H = 1024;
constexpr size_t OFF_NB = OFF_H + (size_t)M * D * 4;
constexpr size_t OFF_Y = OFF_NB + (size_t)M * D * 2;
constexpr size_t OFF_W = OFF_Y + (size_t)M * D * 2;
constexpr size_t W_WIN = 0;
constexpr size_t W_UQ = W_WIN + (size_t)INTOT * 1024 * 2;
constexpr size_t W_UKV = W_UQ + (size_t)384 * 256 * 2;
constexpr size_t W_BR = W_UKV + (size_t)512 * 128 * 2;
constexpr size_t W_OUT = W_BR + (size_t)4 * 1024 * 256 * 2;
constexpr size_t W_FIN = W_OUT + (size_t)1024 * 1024 * 2;
constexpr size_t W_FOUT = W_FIN + (size_t)5632 * 1024 * 2;
constexpr size_t W_END = W_FOUT + (size_t)1024 * DFF * 2;
constexpr size_t OFF_S = al256(OFF_W + W_END);
constexpr size_t S_Z = 0;
constexpr size_t S_CQN = S_Z + (size_t)M * ZLD * 2;
constexpr size_t S_CKVN = S_CQN + (size_t)M * 256 * 2;
constexpr size_t S_QM = S_CKVN + (size_t)M * 128 * 2;
constexpr size_t S_KM = S_QM + (size_t)M * 384 * 2;
constexpr size_t S_VTM = S_KM + (size_t)M * 384 * 2;
constexpr size_t S_VTS = S_VTM + (size_t)16 * 64 * LP * 2;
constexpr size_t S_RWA = S_VTS + (size_t)16 * 64 * LP * 2;
constexpr size_t S_RWB = S_RWA + (size_t)M * 256 * 4;
constexpr size_t S_RWG = S_RWB + (size_t)M * 1280 * 2;
constexpr size_t S_RWBON = S_RWG + (size_t)M * 256 * 2;
constexpr size_t S_GLA = S_RWBON + (size_t)M * 4 * 4;
constexpr size_t S_RWRAW = S_GLA + (size_t)M * 128 * 4;
constexpr size_t S_GLRAW = S_RWRAW + (size_t)M * 256 * 4;
constexpr size_t S_END = S_GLRAW + (size_t)M * 256 * 4;
constexpr size_t S_GATES = 0;
constexpr size_t S_MERGED = S_GATES + (size_t)M * 4096 * 2;
static_assert(S_MERGED + (size_t)M * 1024 * 2 <= S_END, "merged must fit");
constexpr size_t S_AU = 0;
constexpr size_t S_ACT = S_AU + (size_t)MH * 5632 * 2;
constexpr size_t WS_NEED = OFF_S + S_END;

struct Params { const float* in[31]; float* out; char* ws; };
#ifndef PHMASK
#define PHMASK 0xffffffffu
#endif
#define PH(b) if constexpr ((PHMASK >> (b)) & 1u)
constexpr int NTHR = 512, DYN_LDS = 131072;

DI int otid() { int t = threadIdx.x; asm volatile("" : "+v"(t)); return t; }
DI int obid() { int t = blockIdx.x; asm volatile("" : "+s"(t)); return t; }
DI float bf2f(bf16_t v) { return __uint_as_float(((unsigned)v) << 16); }
DI bf16_t f2bf(float f) { unsigned u = __float_as_uint(f); u += 0x7fffu + ((u >> 16) & 1u); return (bf16_t)(u >> 16); }
DI unsigned pack2(float a, float b) { return (unsigned)f2bf(a) | ((unsigned)f2bf(b) << 16); }
DI float wsum(float x) { x += __shfl_xor(x, 32); x += __shfl_xor(x, 16); x += __shfl_xor(x, 8); x += __shfl_xor(x, 4); x += __shfl_xor(x, 2); x += __shfl_xor(x, 1); return x; }
template <int CTRL> DI float dppf(float x) { return __int_as_float(__builtin_amdgcn_update_dpp(0, __float_as_int(x), CTRL, 0xf, 0xf, true)); }
DI float red16(float x) { x += dppf<0xB1>(x); x += dppf<0x4E>(x); x += dppf<0x141>(x); x += dppf<0x140>(x); return x; }
DI float sigmoidf_(float x) { return 1.0f / (1.0f + __expf(-x)); }
DI float softplusf_(float x) { return fmaxf(x, 0.f) + __logf(1.0f + __expf(-fabsf(x))); }
DI float tanhf_(float x) { return 1.0f - 2.0f / (1.0f + __expf(2.0f * x)); }
DI void rope_sc(int tok, int i, float& s, float& c) {
    float fr = exp2f(-(float)i * (13.287712379549449f / 16.0f));
    float ang = (float)tok * fr;
    double rv = (double)ang * 0.15915494309189535;
    rv -= floor(rv);
    float f = (float)rv;
    s = __builtin_amdgcn_sinf(f); c = __builtin_amdgcn_cosf(f);
}
#define MFMA(a, b, c) __builtin_amdgcn_mfma_f32_32x32x16_bf16((a), (b), (c), 0, 0, 0)

namespace pg8 {
#define PG8_LAS __attribute__((address_space(3)))
typedef unsigned short bf16_t;
typedef short bf16x8 __attribute__((ext_vector_type(8)));
typedef float f32x4 __attribute__((ext_vector_type(4)));
typedef unsigned u32x4 __attribute__((ext_vector_type(4)));
constexpr int BM = 256, BK = 64, HALF = 128, HTB = HALF * BK * 2  , STAGE_BYTES = 8 * HTB, NXCD = 8, WGM = 8;

__host__ __device__ __forceinline__ int lds_byte(int r, int c) { const int st = (r >> 4) * 2 + (c >> 5), rr = r & 15, cc = c & 31, ob = rr * 64 + cc * 2; return st * 1024 + (ob ^ (((ob >> 9) & 1) << 5)); }
__host__ __device__ __forceinline__ void stage_rc(int b, int& R, int& C) { const int st = b / 1024, sb = b % 1024, swz = sb ^ (((sb >> 9) & 1) << 5); R = (st >> 1) * 16 + swz / 64; C = (st & 1) * 32 + (swz % 64) / 2; }
__host__ __device__ __forceinline__ int perm32(int rho) { const int n = rho >> 4, i = rho & 15; return 8 * (i >> 2) + 4 * n + (i & 3); }

struct Unit { int pm, pn; };
struct Gemm { const bf16_t* A; const bf16_t* Bt; int M, N, K; };

struct StaticOrder {
    int nM, nN, nwg, G, c;
    __host__ __device__ void init(int M, int N, int G_, int c_) { nM = M / BM; nN = N / BM; nwg = nM * nN; G = G_; c = c_; }
    __host__ __device__ bool next(int i, Unit& u) const {
        const long L = (long)i * G + c; if (L >= nwg) return false;
        int wgid = (int)L; { const int q = nwg / NXCD, r = nwg % NXCD, xcd = wgid % NXCD, off = wgid / NXCD; wgid = (xcd < r ? xcd * (q + 1) : r * (q + 1) + (xcd - r) * q) + off; }
        const int nig = WGM * nN, gid = wgid / nig, fm = gid * WGM, gsz = (nM - fm) < WGM ? (nM - fm) : WGM;
        u.pm = fm + ((wgid % nig) % gsz); u.pn = (wgid % nig) / gsz; return true;
    }
    __device__ __forceinline__ void a_ready(const Unit&) const {}
    __device__ __forceinline__ void done(const Unit&) const {}
};

__device__ __forceinline__ unsigned cvt_pk_bf16(float lo, float hi) { unsigned r; asm volatile("v_cvt_pk_bf16_f32 %0, %1, %2" : "=v"(r) : "v"(lo), "v"(hi)); return r; }
template <class Epi, class Sched, bool ALIGN_EPI = false, bool SP2 = false>
__device__ __forceinline__ void gemm_phase(PG8_LAS unsigned char* lds, const Gemm g, const Sched& S, const Epi& E) {
    const int tid = otid(), wid = __builtin_amdgcn_readfirstlane(tid >> 6), lane = tid & 63, wr = wid >> 2, wc = wid & 3, fr = lane & 15, fq = lane >> 4;
    const int K = g.K, nt = K / BK;
    unsigned voffA[2], voffB[2];
#pragma unroll
    for (int i = 0; i < 2; ++i) { int R, C; stage_rc(tid * 16 + i * 8192, R, C); const int Rb = Epi::PERM ? ((R & ~31) + perm32(R & 31)) : R;
        voffA[i] = (unsigned)(R * K + C) * 2u; voffB[i] = (unsigned)(Rb * K + C) * 2u; }
    const size_t kstep = (size_t)(BK * 2);
    const size_t hstep = (size_t)HALF * K * 2;
    const size_t tstep = 2 * hstep;
    const unsigned ldsw = (unsigned)wid * 1024u;
    const int aoff = lds_byte(wr * 64 + fr, fq * 8), boff = lds_byte(wc * 32 + fr, fq * 8);
#define PG8_SA(b, h) (((b) * 2 + (h)) * HTB)
#define PG8_SB(b, h) ((4 + (b) * 2 + (h)) * HTB)
#define PG8_STAGE(bufoff, gbase, voff) do { _Pragma("unroll") for (int _i = 0; _i < 2; ++_i) \
        __builtin_amdgcn_global_load_lds((const unsigned*)((const char*)(gbase) + (voff)[_i]), (PG8_LAS unsigned*)(lds + (bufoff) + ldsw + _i * 8192), 16, 0, 0); } while (0)
#define PG8_LDA(dst, b, h) do { _Pragma("unroll") for (int m = 0; m < 4; ++m) _Pragma("unroll") for (int k = 0; k < 2; ++k) dst[m][k] = *(const PG8_LAS bf16x8*)(lds + PG8_SA(b, h) + aoff + m * 2048 + k * 1024); } while (0)
#define PG8_LDB(dst, b, h) do { _Pragma("unroll") for (int n = 0; n < 2; ++n) _Pragma("unroll") for (int k = 0; k < 2; ++k) dst[n][k] = *(const PG8_LAS bf16x8*)(lds + PG8_SB(b, h) + boff + n * 2048 + k * 1024); } while (0)
#define PG8_MMA(ai, bj, At, Bt) do { __builtin_amdgcn_s_setprio(1); _Pragma("unroll") for (int m = 0; m < 4; ++m) _Pragma("unroll") for (int n = 0; n < 2; ++n) _Pragma("unroll") for (int k = 0; k < 2; ++k) \
        acc[ai][bj][m][n] = __builtin_amdgcn_mfma_f32_16x16x32_bf16(Bt[n][k], At[m][k], acc[ai][bj][m][n], 0, 0, 0); __builtin_amdgcn_s_setprio(0); } while (0)
#define PG8_WAIT_V(n) asm volatile("s_waitcnt vmcnt(" #n ")" ::: "memory")
#define PG8_WAIT_L(n) asm volatile("s_waitcnt lgkmcnt(" #n ")" ::: "memory")
#define PG8_BAR __builtin_amdgcn_s_barrier()
#define PG8_SCHED __builtin_amdgcn_sched_barrier(0)
    Unit cur, nxt; int ui = 0;
    if (!S.next(0, cur)) return;
    f32x4 acc[2][2][4][2];
#pragma unroll
    for (int a = 0; a < 2; ++a)
#pragma unroll
        for (int b = 0; b < 2; ++b)
#pragma unroll
            for (int m = 0; m < 4; ++m)
#pragma unroll
                for (int n = 0; n < 2; ++n) acc[a][b][m][n] = (f32x4){0.f, 0.f, 0.f, 0.f};
    bf16x8 At[4][2], B0[2][2], B1[2][2];
    const char* cA = (const char*)g.A + (size_t)cur.pm * tstep; const char* cB = (const char*)g.Bt + (size_t)cur.pn * tstep;
    S.a_ready(cur);
    if constexpr (SP2) {
        PG8_STAGE(PG8_SB(0, 0), cB, voffB); PG8_STAGE(PG8_SB(0, 1), cB + hstep, voffB); PG8_STAGE(PG8_SA(0, 0), cA, voffA); PG8_STAGE(PG8_SA(0, 1), cA + hstep, voffA);
        if (wr == 1) PG8_BAR;
        PG8_WAIT_V(2); PG8_BAR;
        PG8_STAGE(PG8_SB(1, 0), cB + kstep, voffB); PG8_STAGE(PG8_SA(1, 0), cA + kstep, voffA); PG8_STAGE(PG8_SB(1, 1), cB + hstep + kstep, voffB);
        PG8_WAIT_V(6); PG8_BAR;
    } else {
        PG8_STAGE(PG8_SB(0, 0), cB, voffB); PG8_STAGE(PG8_SA(0, 0), cA, voffA); PG8_STAGE(PG8_SB(0, 1), cB + hstep, voffB); PG8_STAGE(PG8_SA(0, 1), cA + hstep, voffA);
        if (wr == 1) PG8_BAR;
        PG8_WAIT_V(4); PG8_BAR;
        PG8_STAGE(PG8_SB(1, 0), cB + kstep, voffB); PG8_STAGE(PG8_SA(1, 0), cA + kstep, voffA); PG8_STAGE(PG8_SB(1, 1), cB + hstep + kstep, voffB);
        PG8_WAIT_V(6); PG8_BAR;
    }
    for (;;) {
        const bool has_next = S.next(ui + 1, nxt);
        const char* nA = has_next ? (const char*)g.A + (size_t)nxt.pm * tstep : cA; const char* nB = has_next ? (const char*)g.Bt + (size_t)nxt.pn * tstep : cB;
        for (int t = 0; t < nt; t += 2) {
            const bool last = (t == nt - 2);
            const char* a1 = cA + (size_t)(t + 1) * kstep;
            const char* a2 = last ? nA : cA + (size_t)(t + 2) * kstep; const char* b2 = last ? nB : cB + (size_t)(t + 2) * kstep;
            const char* a3 = a2 + kstep; const char* b3 = b2 + kstep;
            if (last && has_next) S.a_ready(nxt);
            if constexpr (SP2) {
            PG8_LDB(B0, 0, 0); PG8_LDB(B1, 0, 1); PG8_SCHED; PG8_LDA(At, 0, 0); PG8_STAGE(PG8_SA(1, 1), a1 + hstep, voffA);
            PG8_WAIT_V(8); PG8_WAIT_L(0); PG8_BAR; PG8_MMA(0, 0, At, B0); PG8_MMA(0, 1, At, B1); PG8_BAR; PG8_SCHED;
            PG8_LDA(At, 0, 1); PG8_STAGE(PG8_SB(0, 0), b2, voffB); PG8_STAGE(PG8_SB(0, 1), b2 + hstep, voffB); PG8_STAGE(PG8_SA(0, 0), a2, voffA);
            PG8_WAIT_V(8); PG8_WAIT_L(0); PG8_BAR; PG8_MMA(1, 0, At, B0); PG8_MMA(1, 1, At, B1); PG8_BAR; PG8_SCHED;
            PG8_LDB(B0, 1, 0); PG8_LDB(B1, 1, 1); PG8_SCHED; PG8_LDA(At, 1, 0); PG8_STAGE(PG8_SA(0, 1), a2 + hstep, voffA);
            PG8_WAIT_V(8); PG8_WAIT_L(0); PG8_BAR; PG8_MMA(0, 0, At, B0); PG8_MMA(0, 1, At, B1); PG8_BAR; PG8_SCHED;
            PG8_LDA(At, 1, 1); PG8_STAGE(PG8_SB(1, 0), b3, voffB); PG8_STAGE(PG8_SB(1, 1), b3 + hstep, voffB); PG8_STAGE(PG8_SA(1, 0), a3, voffA);
            PG8_WAIT_V(8); PG8_WAIT_L(0); PG8_BAR; PG8_MMA(1, 0, At, B0); PG8_MMA(1, 1, At, B1); PG8_BAR; PG8_SCHED;
            } else {
            PG8_LDB(B0, 0, 0); PG8_SCHED; PG8_LDA(At, 0, 0); PG8_STAGE(PG8_SA(1, 1), a1 + hstep, voffA);
            PG8_WAIT_L(8); PG8_BAR; PG8_WAIT_L(0); PG8_MMA(0, 0, At, B0); PG8_BAR; PG8_SCHED;
            PG8_LDB(B1, 0, 1); PG8_STAGE(PG8_SB(0, 0), b2, voffB);
            PG8_BAR; PG8_WAIT_L(0); PG8_MMA(0, 1, At, B1); PG8_BAR;
            PG8_LDA(At, 0, 1); PG8_STAGE(PG8_SA(0, 0), a2, voffA);
            PG8_BAR; PG8_WAIT_L(0); PG8_MMA(1, 0, At, B0); PG8_BAR; PG8_SCHED;
            PG8_STAGE(PG8_SB(0, 1), b2 + hstep, voffB);
            PG8_WAIT_V(6); PG8_BAR; PG8_MMA(1, 1, At, B1); PG8_BAR;
            PG8_LDB(B0, 1, 0); PG8_SCHED; PG8_LDA(At, 1, 0); PG8_STAGE(PG8_SA(0, 1), a2 + hstep, voffA);
            PG8_WAIT_L(8); PG8_BAR; PG8_WAIT_L(0); PG8_MMA(0, 0, At, B0); PG8_BAR; PG8_SCHED;
            PG8_LDB(B1, 1, 1); PG8_STAGE(PG8_SB(1, 0), b3, voffB);
            PG8_BAR; PG8_WAIT_L(0); PG8_MMA(0, 1, At, B1); PG8_BAR;
            PG8_LDA(At, 1, 1); PG8_STAGE(PG8_SA(1, 0), a3, voffA);
            PG8_BAR; PG8_WAIT_L(0); PG8_MMA(1, 0, At, B0); PG8_BAR; PG8_SCHED;
            PG8_STAGE(PG8_SB(1, 1), b3 + hstep, voffB);
            PG8_WAIT_V(6); PG8_BAR; PG8_MMA(1, 1, At, B1); PG8_BAR;
            }
        }
        if constexpr (ALIGN_EPI) { if (wr == 0) PG8_BAR; }
        if constexpr (!Epi::AFTER_DRAIN) { E(acc, cur, wr, wc, fr, fq); S.done(cur); }
        if (!has_next) break;
#pragma unroll
        for (int a = 0; a < 2; ++a)
#pragma unroll
            for (int b = 0; b < 2; ++b)
#pragma unroll
                for (int m = 0; m < 4; ++m)
#pragma unroll
                    for (int n = 0; n < 2; ++n) acc[a][b][m][n] = (f32x4){0.f, 0.f, 0.f, 0.f};
        cur = nxt; cA = nA; cB = nB; ++ui;
        if constexpr (ALIGN_EPI) { if (wr == 1) PG8_BAR; }
    }
    PG8_WAIT_V(0);
    if constexpr (!ALIGN_EPI) { if (wr == 0) PG8_BAR; }
    PG8_BAR;
    if constexpr (Epi::AFTER_DRAIN) { E.fused(acc, cur, wr, wc, fr, fq, lds, wid, lane); S.done(cur); }
#undef PG8_SA
#undef PG8_SB
#undef PG8_STAGE
#undef PG8_LDA
#undef PG8_LDB
#undef PG8_MMA
#undef PG8_WAIT_V
#undef PG8_WAIT_L
#undef PG8_BAR
#undef PG8_SCHED
}
}

template <int NT>
DI void gemm_tile(f32x16 (&acc)[2][NT], const bf16_t* __restrict__ A, int lda, const bf16_t* __restrict__ Bt, int ldb, int K, bf16_t* lds, int vt) {
    constexpr int BN = 64 * NT;
    bf16_t* As = lds;
    bf16_t* Bs = lds + 2 * 128 * 40;
    const int lane = vt & 63, wave = vt >> 6, wm = wave >> 1, wn = wave & 1, r = lane & 31, hh = lane >> 5;
    uint4 ra[2], rb[NT];
    const int row0 = vt >> 2, kc = vt & 3;
    auto gload = [&](int k0) {
#pragma unroll
        for (int i = 0; i < 2; ++i) ra[i] = *(const uint4*)(A + (size_t)(row0 + 64 * i) * lda + k0 + kc * 8);
#pragma unroll
        for (int i = 0; i < NT; ++i) rb[i] = *(const uint4*)(Bt + (size_t)(row0 + 64 * i) * ldb + k0 + kc * 8);
    };
    auto lstore = [&](int buf) {
#pragma unroll
        for (int i = 0; i < 2; ++i) *(uint4*)(As + buf * 5120 + (row0 + 64 * i) * 40 + kc * 8) = ra[i];
#pragma unroll
        for (int i = 0; i < NT; ++i) *(uint4*)(Bs + buf * BN * 40 + (row0 + 64 * i) * 40 + kc * 8) = rb[i];
    };
    gload(0); lstore(0); __syncthreads();
    const int nk = K >> 5;
    for (int kt = 0; kt < nk; ++kt) {
        const int cur = kt & 1;
        if (kt + 1 < nk) gload((kt + 1) << 5);
#pragma unroll
        for (int s = 0; s < 2; ++s) {
            bf16x8 af[2], bfr[NT];
#pragma unroll
            for (int mt = 0; mt < 2; ++mt) af[mt] = *(const bf16x8*)(As + cur * 5120 + (wm * 64 + mt * 32 + r) * 40 + s * 16 + hh * 8);
#pragma unroll
            for (int nt = 0; nt < NT; ++nt) bfr[nt] = *(const bf16x8*)(Bs + cur * BN * 40 + (wn * 32 * NT + nt * 32 + r) * 40 + s * 16 + hh * 8);
#pragma unroll
            for (int mt = 0; mt < 2; ++mt)
#pragma unroll
                for (int nt = 0; nt < NT; ++nt) acc[mt][nt] = MFMA(af[mt], bfr[nt], acc[mt][nt]);
        }
        if (kt + 1 < nk) lstore(cur ^ 1);
        __syncthreads();
    }
}
template <int NT> DI void acc_zero(f32x16 (&acc)[2][NT]) {
#pragma unroll
    for (int a = 0; a < 2; ++a)
#pragma unroll
        for (int b = 0; b < NT; ++b)
#pragma unroll
            for (int i = 0; i < 16; ++i) acc[a][b][i] = 0.f;
}
template <int NT, class F> DI void epi_foreach(f32x16 (&acc)[2][NT], int m0, int n0, int vt, F f) {
    const int lane = vt & 63, wave = vt >> 6, wm = wave >> 1, wn = wave & 1, r = lane & 31, hh = lane >> 5;
#pragma unroll
    for (int mt = 0; mt < 2; ++mt)
#pragma unroll
        for (int nt = 0; nt < NT; ++nt)
#pragma unroll
            for (int i = 0; i < 16; ++i) f(m0 + wm * 64 + mt * 32 + (i & 3) + 8 * (i >> 2) + 4 * hh, n0 + wn * 32 * NT + nt * 32 + r, acc[mt][nt][i]);
}
template <int NT, class Epi>
DI void phase_gemm_small(const bf16_t* A, int lda, const bf16_t* Bt, int ldb, int Mrows, int N, int K, unsigned char* ldsraw, Epi epi) {
    constexpr int BN = 64 * NT;
    const int tid = otid(), half = tid >> 8, vt = tid & 255, G = gridDim.x, bid = obid();
    bf16_t* lds = (bf16_t*)(ldsraw + half * 40960);
    const int nN = N / BN, nT = (Mrows / 128) * nN, iters = (nT + 2 * G - 1) / (2 * G);
    for (int it = 0; it < iters; ++it) {
        int t = (it * G + bid) * 2 + half; const bool active = t < nT; if (!active) t = nT - 1;
        const int mt = t / nN, nt = t % nN;
        f32x16 acc[2][NT]; acc_zero<NT>(acc);
        gemm_tile<NT>(acc, A + (size_t)mt * 128 * lda, lda, Bt + (size_t)nt * BN * ldb, ldb, K, lds, vt);
        if (active) epi_foreach<NT>(acc, mt * 128, nt * BN, vt, epi);
    }
}

namespace pg8 {
struct EpiStoreBf16 {
    static constexpr bool PERM = true, AFTER_DRAIN = false;
    bf16_t* O; int ldc;
    __device__ __forceinline__ void operator()(const f32x4 (&acc)[2][2][4][2], const Unit& u, int wr, int wc, int fr, int fq) const {
        const int row0 = u.pm * BM + wr * 64 + fr, col0 = u.pn * BM + wc * 32 + 8 * fq;
#pragma unroll
        for (int ai = 0; ai < 2; ++ai)
#pragma unroll
            for (int m = 0; m < 4; ++m) { bf16_t* rowp = O + (size_t)(row0 + ai * HALF + m * 16) * ldc + col0;
#pragma unroll
                for (int bj = 0; bj < 2; ++bj) { const f32x4 v0 = acc[ai][bj][m][0], v1 = acc[ai][bj][m][1];
                    u32x4 w; w.x = cvt_pk_bf16(v0[0], v0[1]); w.y = cvt_pk_bf16(v0[2], v0[3]); w.z = cvt_pk_bf16(v1[0], v1[1]); w.w = cvt_pk_bf16(v1[2], v1[3]);
                    *(u32x4*)(rowp + bj * HALF) = w; } }
    }
};
struct EpiGate {
    static constexpr bool PERM = true, AFTER_DRAIN = false;
    bf16_t* O; int ldc; const float* bias;
    __device__ __forceinline__ void operator()(const f32x4 (&acc)[2][2][4][2], const Unit& u, int wr, int wc, int fr, int fq) const {
        const int row0 = u.pm * BM + wr * 64 + fr, col0 = u.pn * BM + wc * 32 + 8 * fq;
        f32x4 bv[2][2];
#pragma unroll
        for (int bj = 0; bj < 2; ++bj)
#pragma unroll
            for (int n = 0; n < 2; ++n) bv[bj][n] = *(const f32x4*)(bias + col0 + bj * HALF + 4 * n);
#pragma unroll
        for (int ai = 0; ai < 2; ++ai)
#pragma unroll
            for (int m = 0; m < 4; ++m) { bf16_t* rowp = O + (size_t)(row0 + ai * HALF + m * 16) * ldc + col0;
#pragma unroll
                for (int bj = 0; bj < 2; ++bj) { f32x4 v0 = acc[ai][bj][m][0] + bv[bj][0], v1 = acc[ai][bj][m][1] + bv[bj][1];
#pragma unroll
                    for (int e = 0; e < 4; ++e) { v0[e] = 1.0f / (1.0f + __expf(-v0[e])); v1[e] = 1.0f / (1.0f + __expf(-v1[e])); }
                    u32x4 w; w.x = cvt_pk_bf16(v0[0], v0[1]); w.y = cvt_pk_bf16(v0[2], v0[3]); w.z = cvt_pk_bf16(v1[0], v1[1]); w.w = cvt_pk_bf16(v1[2], v1[3]);
                    *(u32x4*)(rowp + bj * HALF) = w; } }
    }
};
struct EpiResid {
    static constexpr bool PERM = true, AFTER_DRAIN = false;
    float* h; int row_off;
    __device__ __forceinline__ void operator()(const f32x4 (&acc)[2][2][4][2], const Unit& u, int wr, int wc, int fr, int fq) const {
        const int row0 = row_off + u.pm * BM + wr * 64 + fr, col0 = u.pn * BM + wc * 32 + 8 * fq;
#pragma unroll
        for (int ai = 0; ai < 2; ++ai)
#pragma unroll
            for (int m = 0; m < 4; ++m) { const int R = row0 + ai * HALF + m * 16;
                if (R % LP >= PADF) { float* rowp = h + (size_t)R * 1024 + col0;
#pragma unroll
                    for (int bj = 0; bj < 2; ++bj) { f32x4* p0 = (f32x4*)(rowp + bj * HALF); f32x4* p1 = p0 + 1;
                        const f32x4 o0 = *p0, o1 = *p1; *p0 = o0 + acc[ai][bj][m][0]; *p1 = o1 + acc[ai][bj][m][1]; } } }
    }
};
}
DI void convT(const float* __restrict__ W, int K, int N, bf16_t* __restrict__ Wt, int gtid, int gthreads) {
    const int K8 = K >> 3; const long total = (long)N * K8;
    for (long u = gtid; u < total; u += gthreads) {
        const int n = (int)(u % N), k8 = (int)(u / N);
        const float* src = W + (size_t)(k8 * 8) * N + n;
        float v[8];
#pragma unroll
        for (int j = 0; j < 8; ++j) v[j] = src[(size_t)j * N];
        uint4 o; o.x = pack2(v[0], v[1]); o.y = pack2(v[2], v[3]); o.z = pack2(v[4], v[5]); o.w = pack2(v[6], v[7]);
        *(uint4*)(Wt + (size_t)n * K + k8 * 8) = o;
    }
}

DI void phase_norm(int mode, const Params& p, float* h, const float* __restrict__ g, bf16_t* nb) {
    const int lane = otid() & 63, wv = otid() >> 6;
    for (int R = obid() * 8 + wv; R < M; R += gridDim.x * 8) {
        const int b = R / LP, pos = R % LP;
        const float* src = h + (size_t)R * D; bool zero = false;
        if (mode == 1) { if (pos < PADF) zero = true; else if (pos < 128) src = p.in[1] + (size_t)(pos - PADF) * D; else src = p.in[0] + ((size_t)b * SEQ + pos - 128) * D; }
        if (mode == 2 && pos < 128) continue;
        float4 v[4]; float ss = 0.f;
#pragma unroll
        for (int i = 0; i < 4; ++i) {
            v[i] = zero ? make_float4(0.f, 0.f, 0.f, 0.f) : *(const float4*)(src + i * 256 + lane * 4);
            ss += v[i].x * v[i].x + v[i].y * v[i].y + v[i].z * v[i].z + v[i].w * v[i].w;
        }
        ss = wsum(ss);
        const float rs = rsqrtf(ss * (1.0f / 1024.0f) + 1e-6f);
#pragma unroll
        for (int i = 0; i < 4; ++i) {
            const float4 gg = *(const float4*)(g + i * 256 + lane * 4);
            float4 o; o.x = v[i].x * rs * gg.x; o.y = v[i].y * rs * gg.y; o.z = v[i].z * rs * gg.z; o.w = v[i].w * rs * gg.w;
            if (mode == 2) *(float4*)(p.out + ((size_t)b * SEQ + pos - 128) * D + i * 256 + lane * 4) = o;
            else {
                if (mode == 1) *(float4*)(h + (size_t)R * D + i * 256 + lane * 4) = v[i];
                uint2 w; w.x = pack2(o.x, o.y); w.y = pack2(o.z, o.w);
                *(uint2*)(nb + (size_t)R * D + i * 256 + lane * 4) = w;
            }
        }
    }
}

struct LayerW {
    const float *q_norm, *kv_norm, *mu, *w0, *w2, *a0, *a2, *g2, *k_k, *k_a, *r_k, *ln_w, *ln_b, *gla_a2, *gla_a_b, *gla_norm, *gate_b, *conv_w, *conv_b;
};
constexpr int TB = 8;
DI void phase_prep(const LayerW& L, char* S, float* zin0) {
    const bf16_t* Z = (const bf16_t*)(S + S_Z);
    bf16_t* cqn = (bf16_t*)(S + S_CQN); bf16_t* ckvn = (bf16_t*)(S + S_CKVN); bf16_t* Km = (bf16_t*)(S + S_KM);
    bf16_t* VTs = (bf16_t*)(S + S_VTS); float* rwA = (float*)(S + S_RWA); bf16_t* rwB = (bf16_t*)(S + S_RWB);
    bf16_t* rwG = (bf16_t*)(S + S_RWG); float* rwBon = (float*)(S + S_RWBON); float* glA = (float*)(S + S_GLA);
    const int tid0 = otid(), half = tid0 >> 8, tid = tid0 & 255, lane = tid & 63, wv = tid >> 6, G = gridDim.x, bid = obid();
    float* zin = zin0 + half * TB * 256;
    constexpr int NG = M / TB;
    const int iters = (NG + 2 * G - 1) / (2 * G);
    for (int it = 0; it < iters; ++it) {
        const int grp = (it * G + bid) * 2 + half; const bool active = grp < NG;
        const int R0 = (active ? grp : 0) * TB, b = R0 / LP, pos0 = R0 % LP;
        {
            const int ch = 768 + tid; const float mu = L.mu[ch];
            for (int i = 0; i < TB; ++i) {
                const int R = R0 + i, tok = pos0 + i - PADF;
                const float zc = bf2f(Z[(size_t)R * ZLD + ZC_RW + ch]);
                const float zp = (tok > 0) ? bf2f(Z[(size_t)(R - 1) * ZLD + ZC_RW + ch]) : 0.f;
                const float zs = zc + (zp - zc) * mu;
                zin[i * 256 + tid] = tid < 64 ? tanhf_(zs) : (tid < 128 ? zs : sigmoidf_(zs));
            }
        }
        __syncthreads();
        float aw[TB], aa[TB], ag[TB];
#pragma unroll
        for (int i = 0; i < TB; ++i) { aw[i] = 0.f; aa[i] = 0.f; ag[i] = 0.f; }
        for (int j = 0; j < 64; j += 4) {
            float w2v[4], a2v[4];
#pragma unroll
            for (int q = 0; q < 4; ++q) { w2v[q] = L.w2[(j + q) * 256 + tid]; a2v[q] = L.a2[(j + q) * 256 + tid]; }
#pragma unroll
            for (int tk = 0; tk < TB; ++tk) {
                const float4 zw = *(const float4*)(zin + tk * 256 + j);
                const float4 za = *(const float4*)(zin + tk * 256 + 64 + j);
                aw[tk] += zw.x * w2v[0] + zw.y * w2v[1] + zw.z * w2v[2] + zw.w * w2v[3];
                aa[tk] += za.x * a2v[0] + za.y * a2v[1] + za.z * a2v[2] + za.w * a2v[3];
            }
        }
        for (int j = 0; j < 128; j += 4) {
            float g2v[4];
#pragma unroll
            for (int q = 0; q < 4; ++q) g2v[q] = L.g2[(j + q) * 256 + tid];
#pragma unroll
            for (int tk = 0; tk < TB; ++tk) {
                const float4 zg = *(const float4*)(zin + tk * 256 + 128 + j);
                ag[tk] += zg.x * g2v[0] + zg.y * g2v[1] + zg.z * g2v[2] + zg.w * g2v[3];
            }
        }
        {
            const float mur = L.mu[tid], muk = L.mu[256 + tid], muv = L.mu[512 + tid];
            const float w0 = L.w0[tid], a0 = L.a0[tid], kkc = L.k_k[tid], kac = L.k_a[tid], rkc = L.r_k[tid];
#pragma unroll
            for (int tk = 0; tk < TB; ++tk) {
                const int R = R0 + tk, tok = pos0 + tk - PADF;
                const bf16_t* zr = Z + (size_t)R * ZLD + ZC_RW;
                float rc = bf2f(zr[tid]), kcur = bf2f(zr[256 + tid]), vc = bf2f(zr[512 + tid]);
                float rp = 0.f, kp = 0.f, vp = 0.f;
                if (tok > 0) { const bf16_t* zq = zr - ZLD; rp = bf2f(zq[tid]); kp = bf2f(zq[256 + tid]); vp = bf2f(zq[512 + tid]); }
                const float r = rc + (rp - rc) * mur, k = kcur + (kp - kcur) * muk, v = vc + (vp - vc) * muv;
                const float wv_ = -softplusf_(-(w0 + aw[tk])) - 0.5f;
                const float decay = __expf(-__expf(wv_));
                const float a = sigmoidf_(a0 + aa[tk]);
                const float kkr = k * kkc;
                const float nrm = sqrtf(wsum(kkr * kkr));
                const float kk = kkr / fmaxf(nrm, 1e-12f);
                const float k2 = k * (1.0f + (a - 1.0f) * kac);
                const float bon = wsum(r * k2 * rkc);
                rwA[(size_t)R * 256 + tid] = decay;
                bf16_t* o = rwB + (size_t)R * 1280 + tid;
                o[0] = f2bf(r); o[256] = f2bf(k2); o[512] = f2bf(v); o[768] = f2bf(kk); o[1024] = f2bf(kk * a);
                rwG[(size_t)R * 256 + tid] = f2bf(ag[tk]);
                if (lane == 0) rwBon[(size_t)R * 4 + wv] = bon;
            }
        }
        for (int q = 0; q < TB / 4; ++q) {
            const int R = R0 + wv * (TB / 4) + q, tok = pos0 + wv * (TB / 4) + q - PADF;
            const bf16_t* zr = Z + (size_t)R * ZLD;
            {
                const uint2 raw = *(const uint2*)(zr + ZC_CQ + lane * 4);
                const float x0 = __uint_as_float(raw.x << 16), x1 = __uint_as_float(raw.x & 0xffff0000u), x2 = __uint_as_float(raw.y << 16), x3 = __uint_as_float(raw.y & 0xffff0000u);
                const float ss = wsum(x0 * x0 + x1 * x1 + x2 * x2 + x3 * x3);
                const float rs = rsqrtf(ss * (1.0f / 256.0f) + 1e-6f);
                const float4 gq = *(const float4*)(L.q_norm + lane * 4);
                uint2 w; w.x = pack2(x0 * rs * gq.x, x1 * rs * gq.y); w.y = pack2(x2 * rs * gq.z, x3 * rs * gq.w);
                *(uint2*)(cqn + (size_t)R * 256 + lane * 4) = w;
            }
            {
                const unsigned raw = *(const unsigned*)(zr + ZC_CKV + lane * 2);
                const float x0 = __uint_as_float(raw << 16), x1 = __uint_as_float(raw & 0xffff0000u);
                const float ss = wsum(x0 * x0 + x1 * x1);
                const float rs = rsqrtf(ss * (1.0f / 128.0f) + 1e-6f);
                *(unsigned*)(ckvn + (size_t)R * 128 + lane * 2) = pack2(x0 * rs * L.kv_norm[lane * 2], x1 * rs * L.kv_norm[lane * 2 + 1]);
            }
            if (lane < 16) {
                const float x1 = bf2f(zr[ZC_KR + lane]), x2 = bf2f(zr[ZC_KR + 16 + lane]);
                float sn, cs; rope_sc(tok, lane, sn, cs);
                const bf16_t o1 = f2bf(x1 * cs - x2 * sn), o2 = f2bf(x1 * sn + x2 * cs);
#pragma unroll
                for (int hd = 0; hd < 4; ++hd) { Km[(size_t)R * 384 + hd * 96 + 64 + lane] = o1; Km[(size_t)R * 384 + hd * 96 + 80 + lane] = o2; }
            }
        }
        for (int i = 0; i < TB / 2; ++i) {
            const int idx = tid + 256 * i, tk = idx >> 7, c = idx & 127, R = R0 + tk;
            const bf16_t* al = Z + (size_t)R * ZLD + ZC_GLA + 512;
            float x = L.gla_a_b[c];
#pragma unroll
            for (int j = 0; j < 16; ++j) x += bf2f(al[j]) * L.gla_a2[j * 128 + c];
            const float ls = fminf(x, 0.f) - __logf(1.0f + __expf(-fabsf(x)));
            glA[(size_t)R * 128 + c] = __expf(ls * (1.0f / 16.0f));
        }
        {
            unsigned pk[4];
#pragma unroll
            for (int tk = 0; tk < TB; tk += 2) {
                const unsigned lo = Z[(size_t)(R0 + tk) * ZLD + ZC_SB + 512 + tid], hi = Z[(size_t)(R0 + tk + 1) * ZLD + ZC_SB + 512 + tid];
                pk[tk >> 1] = lo | (hi << 16);
            }
            bf16_t* dst = VTs + ((size_t)((b * 4 + (tid >> 6)) * 64 + (tid & 63))) * LP + pos0;
            *(uint4*)dst = make_uint4(pk[0], pk[1], pk[2], pk[3]);
        }
        __syncthreads();
    }
}

template <bool SB>
DI void attn_item(int bh, int qblk, const bf16_t* __restrict__ Qb, const bf16_t* __restrict__ Kb, int stride, const bf16_t* __restrict__ VT, bf16_t* __restrict__ y, int ycol0) {
    constexpr int KS = SB ? 4 : 6, HD = SB ? 64 : 96;
    const float scale = SB ? 0.125f : 0.10206207261596575f;
    const int lane = otid() & 63, wave = otid() >> 6, r = lane & 31, hh = lane >> 5;
    const int b = bh >> 2, h = bh & 3;
    const int qb32 = qblk * 8 + wave, qpos = qb32 * 32 + r;
    if (qb32 >= LP / 32) return;
    const bf16_t* Qrow = Qb + (size_t)(b * LP + qpos) * stride + h * HD;
    bf16x8 qf[KS];
#pragma unroll
    for (int s = 0; s < KS; ++s) qf[s] = *(const bf16x8*)(Qrow + 16 * s + 8 * hh);
    if (!SB) {
#pragma unroll
        for (int j = 0; j < 8; ++j) {
            float sn, cs; rope_sc(qpos - PADF, 8 * hh + j, sn, cs);
            const float x1 = bf2f((bf16_t)qf[KS - 2][j]), x2 = bf2f((bf16_t)qf[KS - 1][j]);
            qf[KS - 2][j] = (short)f2bf(x1 * cs - x2 * sn); qf[KS - 1][j] = (short)f2bf(x1 * sn + x2 * cs);
        }
    }
    const bf16_t* Kbase = Kb + (size_t)(b * LP) * stride + h * HD;
    const bf16_t* VTb = VT + (size_t)(bh * 64) * LP;
    f32x16 O[2];
#pragma unroll
    for (int i = 0; i < 16; ++i) { O[0][i] = 0.f; O[1][i] = 0.f; }
    float mrun = -1e30f, lrun = 0.f, Lc = 0.f;
    for (int kb = qb32; kb >= 3; --kb) {
        const int kpos0 = kb * 32;
        bf16x8 kf[KS];
#pragma unroll
        for (int s = 0; s < KS; ++s) kf[s] = *(const bf16x8*)(Kbase + (size_t)(kpos0 + r) * stride + 16 * s + 8 * hh);
        bf16x8 vf[2][2];
#pragma unroll
        for (int mt = 0; mt < 2; ++mt)
#pragma unroll
            for (int s2 = 0; s2 < 2; ++s2) {
                const bf16_t* vp = VTb + (size_t)(mt * 32 + r) * LP + kpos0 + 16 * s2 + 4 * hh;
                const s16x4 lo = *(const s16x4*)vp, hi = *(const s16x4*)(vp + 8);
                vf[mt][s2] = __builtin_shufflevector(lo, hi, 0, 1, 2, 3, 4, 5, 6, 7);
            }
        f32x16 Sx;
#pragma unroll
        for (int i = 0; i < 16; ++i) Sx[i] = 0.f;
#pragma unroll
        for (int s = 0; s < KS; ++s) Sx = MFMA(kf[s], qf[s], Sx);
        const bool edge = (kb == qb32) || (kb == 3);
        float pv[16];
        if (!SB) {
            float zmax = -1e30f;
#pragma unroll
            for (int i = 0; i < 16; ++i) {
                float z = Sx[i] * scale;
                if (edge) { const int key = kpos0 + (i & 3) + 8 * (i >> 2) + 4 * hh; z = (key >= PADF && key <= qpos) ? z : -1e30f; }
                Sx[i] = z; zmax = fmaxf(zmax, z);
            }
            zmax = fmaxf(zmax, __shfl_xor(zmax, 32));
            const float mnew = fmaxf(mrun, zmax), alpha = __expf(mrun - mnew);
            float ps = 0.f;
#pragma unroll
            for (int i = 0; i < 16; ++i) { pv[i] = __expf(Sx[i] - mnew); ps += pv[i]; }
            lrun = lrun * alpha + ps; mrun = mnew;
#pragma unroll
            for (int i = 0; i < 16; ++i) { O[0][i] *= alpha; O[1][i] *= alpha; }
        } else {
            float lk[16], ls[16]; unsigned okm = 0;
#pragma unroll
            for (int i = 0; i < 16; ++i) {
                const float z = Sx[i] * scale, sp = softplusf_(z);
                bool ok = true;
                if (edge) { const int key = kpos0 + (i & 3) + 8 * (i >> 2) + 4 * hh; ok = (key >= PADF && key < qpos); }
                lk[i] = ok ? -sp : 0.f; ls[i] = z - sp; okm |= (ok ? 1u : 0u) << i;
            }
            float gs[4], pg[4];
#pragma unroll
            for (int q = 0; q < 4; ++q) { gs[q] = (lk[4 * q] + lk[4 * q + 1]) + (lk[4 * q + 2] + lk[4 * q + 3]); pg[q] = __shfl_xor(gs[q], 32); }
            float T[4]; float run = 0.f;
#pragma unroll
            for (int q = 3; q >= 0; --q) { T[q] = run + (hh == 0 ? pg[q] : 0.f); run += gs[q] + pg[q]; }
#pragma unroll
            for (int q = 0; q < 4; ++q) {
                float wsuf = 0.f;
#pragma unroll
                for (int e = 3; e >= 0; --e) {
                    const int i = 4 * q + e;
                    const float later = Lc + T[q] + wsuf;
                    pv[i] = ((okm >> i) & 1u) ? __expf(ls[i] + later) : 0.f;
                    wsuf += lk[i];
                }
            }
            Lc += run;
        }
        bf16x8 pb[2];
#pragma unroll
        for (int s2 = 0; s2 < 2; ++s2) {
            uint4 w; w.x = pack2(pv[8 * s2], pv[8 * s2 + 1]); w.y = pack2(pv[8 * s2 + 2], pv[8 * s2 + 3]); w.z = pack2(pv[8 * s2 + 4], pv[8 * s2 + 5]); w.w = pack2(pv[8 * s2 + 6], pv[8 * s2 + 7]);
            pb[s2] = __builtin_bit_cast(bf16x8, w);
        }
#pragma unroll
        for (int mt = 0; mt < 2; ++mt)
#pragma unroll
            for (int s2 = 0; s2 < 2; ++s2) O[mt] = MFMA(vf[mt][s2], pb[s2], O[mt]);
    }
    float inv = 1.0f;
    if (!SB) { const float lt = lrun + __shfl_xor(lrun, 32); inv = 1.0f / lt; }
    bf16_t* yrow = y + (size_t)(b * LP + qpos) * 1024 + ycol0 + h * 64;
#pragma unroll
    for (int mt = 0; mt < 2; ++mt)
#pragma unroll
        for (int g = 0; g < 4; ++g) {
            uint2 w; w.x = pack2(O[mt][4 * g] * inv, O[mt][4 * g + 1] * inv); w.y = pack2(O[mt][4 * g + 2] * inv, O[mt][4 * g + 3] * inv);
            *(uint2*)(yrow + mt * 32 + 8 * g + 4 * hh) = w;
        }
}

DI void rwkv_item(int item, char* S, float* lds) {
    const float* rwA = (const float*)(S + S_RWA); const bf16_t* rwB = (const bf16_t*)(S + S_RWB); float* raw = (float*)(S + S_RWRAW);
    const int bh = item >> 1, rg = item & 1, b = bh >> 2, h = bh & 3;
    const int tid = otid(), lane = tid & 63, wave = tid >> 6, part = lane & 15, rowl = wave * 4 + (lane >> 4);
    float* vecb = lds;
    float* vb = lds + 2 * 5120;
    const size_t Rb = (size_t)b * LP + PADF;
    float4 st[3]; float sv;
    auto gload = [&](int c) {
#pragma unroll
        for (int i = 0; i < 3; ++i) {
            const int idx = tid + 512 * i, step = idx / 80, rem = idx % 80, vec = rem >> 4, c4 = rem & 15;
            const size_t R = Rb + c * 16 + step;
            if (idx >= 1280) {}
            else if (vec == 1) st[i] = *(const float4*)(rwA + R * 256 + h * 64 + c4 * 4);
            else {
                const int plane = vec == 0 ? 3 : (vec == 2 ? 4 : (vec == 3 ? 1 : 0));
                const uint2 raw2 = *(const uint2*)(rwB + R * 1280 + plane * 256 + h * 64 + c4 * 4);
                st[i] = make_float4(__uint_as_float(raw2.x << 16), __uint_as_float(raw2.x & 0xffff0000u), __uint_as_float(raw2.y << 16), __uint_as_float(raw2.y & 0xffff0000u));
            }
        }
        { const int step = tid >> 5, row = tid & 31; sv = bf2f(rwB[(Rb + c * 16 + step) * 1280 + 512 + h * 64 + rg * 32 + row]); }
    };
    auto lstore = [&](int buf) {
#pragma unroll
        for (int i = 0; i < 3; ++i) {
            const int idx = tid + 512 * i, step = idx / 80, rem = idx % 80, vec = rem >> 4, c4 = rem & 15;
            if (idx < 1280) *(float4*)(vecb + buf * 5120 + step * 320 + vec * 64 + c4 * 4) = st[i];
        }
        vb[buf * 512 + tid] = sv;
    };
    gload(0); lstore(0); __syncthreads();
    float4 Sx = make_float4(0.f, 0.f, 0.f, 0.f);
    constexpr int NC = LTOK / 16;
    for (int c = 0; c < NC; ++c) {
        const int cur = c & 1;
        if (c + 1 < NC) gload(c + 1);
        const float* vbp = vecb + cur * 5120 + part * 4;
#pragma unroll 4
        for (int s = 0; s < 16; ++s) {
            const float4 kk = *(const float4*)(vbp + s * 320), w = *(const float4*)(vbp + s * 320 + 64), kka = *(const float4*)(vbp + s * 320 + 128);
            const float4 k = *(const float4*)(vbp + s * 320 + 192), rr = *(const float4*)(vbp + s * 320 + 256);
            const float vv = vb[cur * 512 + s * 32 + rowl];
            float sa = (Sx.x * kk.x + Sx.y * kk.y) + (Sx.z * kk.z + Sx.w * kk.w);
            sa = red16(sa);
            Sx.x = Sx.x * w.x + (vv * k.x - sa * kka.x);
            Sx.y = Sx.y * w.y + (vv * k.y - sa * kka.y);
            Sx.z = Sx.z * w.z + (vv * k.z - sa * kka.z);
            Sx.w = Sx.w * w.w + (vv * k.w - sa * kka.w);
            float yy = (Sx.x * rr.x + Sx.y * rr.y) + (Sx.z * rr.z + Sx.w * rr.w);
            yy = red16(yy);
            if (part == 0) raw[(Rb + c * 16 + s) * 256 + h * 64 + rg * 32 + rowl] = yy;
        }
        if (c + 1 < NC) lstore(cur ^ 1);
        __syncthreads();
    }
}

DI void gla_item(int item, char* S, float* lds) {
    const float* glA = (const float*)(S + S_GLA); const bf16_t* Z = (const bf16_t*)(S + S_Z); float* raw = (float*)(S + S_GLRAW);
    const int bh = item >> 1, rg = item & 1, b = bh >> 2, h = bh & 3;
    const int tid = otid(), lane = tid & 63, wave = tid >> 6, part = lane & 15, rowl = wave * 4 + (lane >> 4);
    float* vecb = lds;
    float* vb = lds + 2 * 1536;
    const size_t Rb = (size_t)b * LP + PADF;
    float4 st[1]; float sv;
    auto gload = [&](int c) {
#pragma unroll
        for (int i = 0; i < 1; ++i) {
            const int idx = tid;
            if (idx < 384) {
                const int step = idx / 24, rem = idx % 24, vec = rem >> 3, c4 = rem & 7;
                const size_t R = Rb + c * 16 + step;
                if (vec == 0) st[i] = *(const float4*)(glA + R * 128 + h * 32 + c4 * 4);
                else {
                    const uint2 raw2 = *(const uint2*)(Z + R * ZLD + ZC_GLA + (vec == 1 ? 128 : 0) + h * 32 + c4 * 4);
                    st[i] = make_float4(__uint_as_float(raw2.x << 16), __uint_as_float(raw2.x & 0xffff0000u), __uint_as_float(raw2.y << 16), __uint_as_float(raw2.y & 0xffff0000u));
                }
            }
        }
        { const int step = tid >> 5, row = tid & 31; sv = bf2f(Z[(Rb + c * 16 + step) * ZLD + ZC_GLA + 256 + h * 64 + rg * 32 + row]); }
    };
    auto lstore = [&](int buf) {
#pragma unroll
        for (int i = 0; i < 1; ++i) {
            const int idx = tid;
            if (idx < 384) { const int step = idx / 24, rem = idx % 24, vec = rem >> 3, c4 = rem & 7; *(float4*)(vecb + buf * 1536 + step * 96 + vec * 32 + c4 * 4) = st[i]; }
        }
        vb[buf * 512 + tid] = sv;
    };
    gload(0); lstore(0); __syncthreads();
    float s0 = 0.f, s1 = 0.f;
    constexpr int NC = LTOK / 16;
    for (int c = 0; c < NC; ++c) {
        const int cur = c & 1;
        if (c + 1 < NC) gload(c + 1);
        const float* vbp = vecb + cur * 1536 + part * 2;
#pragma unroll 4
        for (int s = 0; s < 16; ++s) {
            const float2 a = *(const float2*)(vbp + s * 96), k = *(const float2*)(vbp + s * 96 + 32), q = *(const float2*)(vbp + s * 96 + 64);
            const float vv = vb[cur * 512 + s * 32 + rowl];
            s0 = a.x * s0 + k.x * vv; s1 = a.y * s1 + k.y * vv;
            float o = red16(q.x * s0 + q.y * s1);
            if (part == 0) raw[(Rb + c * 16 + s) * 256 + h * 64 + rg * 32 + rowl] = o;
        }
        if (c + 1 < NC) lstore(cur ^ 1);
        __syncthreads();
    }
}


__global__ void __launch_bounds__(NTHR, 2) mega(Params p) {
    cg::grid_group grid = cg::this_grid();
    extern __shared__ __attribute__((aligned(16))) unsigned char dynlds[];
    __shared__ int s_item;
    PG8_LAS unsigned char* ldsL = (PG8_LAS unsigned char*)dynlds;
    float* ldsf = (float*)dynlds;
    char* ws = p.ws;
    unsigned* ctr = (unsigned*)(ws + OFF_CTR);
    float* h = (float*)(ws + OFF_H); bf16_t* nb = (bf16_t*)(ws + OFF_NB); bf16_t* y = (bf16_t*)(ws + OFF_Y);
    char* Wb = ws + OFF_W; char* S = ws + OFF_S;
    bf16_t* winT = (bf16_t*)(Wb + W_WIN); bf16_t* uqT = (bf16_t*)(Wb + W_UQ); bf16_t* ukvT = (bf16_t*)(Wb + W_UKV); bf16_t* brT = (bf16_t*)(Wb + W_BR);
    bf16_t* woutT = (bf16_t*)(Wb + W_OUT); bf16_t* finT = (bf16_t*)(Wb + W_FIN); bf16_t* foutT = (bf16_t*)(Wb + W_FOUT);
    bf16_t* Z = (bf16_t*)(S + S_Z); bf16_t* cqn = (bf16_t*)(S + S_CQN); bf16_t* ckvn = (bf16_t*)(S + S_CKVN); bf16_t* Qm = (bf16_t*)(S + S_QM); bf16_t* Km = (bf16_t*)(S + S_KM);
    bf16_t* VTm = (bf16_t*)(S + S_VTM); bf16_t* VTs = (bf16_t*)(S + S_VTS); bf16_t* merged = (bf16_t*)(S + S_MERGED); bf16_t* gates = (bf16_t*)(S + S_GATES);
    bf16_t* au = (bf16_t*)(S + S_AU); bf16_t* act = (bf16_t*)(S + S_ACT);
    const int gthreads = gridDim.x * NTHR, G = gridDim.x;

    for (int layer = 0; layer < 4; ++layer) {
        LayerW L;
        L.q_norm = p.in[4] + layer * 256; L.kv_norm = p.in[6] + layer * 128; L.mu = p.in[8] + layer * 1024; L.w0 = p.in[9] + layer * 256;
        L.w2 = p.in[10] + layer * 64 * 256; L.a0 = p.in[11] + layer * 256; L.a2 = p.in[12] + layer * 64 * 256; L.g2 = p.in[13] + layer * 128 * 256;
        L.k_k = p.in[14] + layer * 256; L.k_a = p.in[15] + layer * 256; L.r_k = p.in[16] + layer * 256; L.ln_w = p.in[17] + layer * 256; L.ln_b = p.in[18] + layer * 256;
        L.gla_a2 = p.in[19] + layer * 16 * 128; L.gla_a_b = p.in[20] + layer * 128; L.gla_norm = p.in[21] + layer * 256; L.gate_b = p.in[22] + layer * 4096;
        L.conv_w = p.in[27] + layer * 3 * DFF; L.conv_b = p.in[28] + layer * DFF;

        PH(0) { const int gtid = obid() * NTHR + otid();
            convT(p.in[3] + (size_t)layer * 1024 * INTOT, 1024, INTOT, winT, gtid, gthreads);
            convT(p.in[5] + (size_t)layer * 256 * 384, 256, 384, uqT, gtid, gthreads);
            convT(p.in[7] + (size_t)layer * 128 * 512, 128, 512, ukvT, gtid, gthreads);
            for (int n = 0; n < 4; ++n) convT(p.in[23] + ((size_t)layer * 4 + n) * 256 * 1024, 256, 1024, brT + (size_t)n * 1024 * 256, gtid, gthreads);
            convT(p.in[24] + (size_t)layer * 1024 * 1024, 1024, 1024, woutT, gtid, gthreads);
            convT(p.in[26] + (size_t)layer * 1024 * 5632, 1024, 5632, finT, gtid, gthreads);
            convT(p.in[29] + (size_t)layer * DFF * 1024, DFF, 1024, foutT, gtid, gthreads);
            phase_norm(layer == 0 ? 1 : 0, p, h, p.in[2] + layer * 1024, nb);
        }
        grid.sync();

        PH(1) { pg8::Gemm g{nb, winT, M, ZLD, 1024}; pg8::StaticOrder So; So.init(M, ZLD, G, obid()); pg8::EpiStoreBf16 E{Z, ZLD};
            pg8::gemm_phase<pg8::EpiStoreBf16, pg8::StaticOrder, true, true>(ldsL, g, So, E); }
        grid.sync();

        PH(2) phase_prep(L, S, ldsf);
        grid.sync();

        PH(3) phase_gemm_small<2>(cqn, 256, uqT, 256, M, 384, 256, dynlds,
                      [&](int row, int col, float v) { Qm[(size_t)row * 384 + col] = f2bf(v); });
        PH(4) phase_gemm_small<2>(ckvn, 128, ukvT, 128, M, 512, 128, dynlds,
                      [&](int row, int col, float v) {
                          const int hd = col >> 7, c = col & 127;
                          if (c < 64) Km[(size_t)row * 384 + hd * 96 + c] = f2bf(v);
                          else { const int b = row / LP, pos = row % LP; VTm[((size_t)((b * 4 + hd) * 64 + (c - 64))) * LP + pos] = f2bf(v); }
                      });
        grid.sync();

        for (;;) {
            const int tid = otid();
            if (tid == 0) s_item = (int)atomicAdd(ctr + layer, 1u);
            __syncthreads();
            const int item = s_item;
            __syncthreads();
            if (item >= 64 + 17 * 32) break;
            if (item < 32) { PH(5) rwkv_item(item, S, ldsf); }
            else if (item < 64) { PH(6) gla_item(item - 32, S, ldsf); }
            else {
                const int a = item - 64, qblk = 16 - a / 32, rem = a % 32, bh = rem & 15;
                if (rem < 16) { PH(7) attn_item<false>(bh, qblk, Qm, Km, 384, VTm, y, 0); }
                else { PH(8) attn_item<true>(bh, qblk, Z + ZC_SB, Z + ZC_SB + 256, ZLD, VTs, y, 512); }
            }
        }
        grid.sync();

        PH(9) {
            const float* rwRaw = (const float*)(S + S_RWRAW); const float* glRaw = (const float*)(S + S_GLRAW);
            const bf16_t* rwB = (const bf16_t*)(S + S_RWB); const bf16_t* rwG = (const bf16_t*)(S + S_RWG); const float* rwBon = (const float*)(S + S_RWBON);
            const int tid0 = otid(), half = tid0 >> 8, tid = tid0 & 255;
            const float lnw = L.ln_w[tid], lnb = L.ln_b[tid], gn = L.gla_norm[tid];
            for (int R = obid() * 2 + half; R < M; R += 2 * G) {
                if (R % LP < PADF) continue;
                {
                    const float yv = rwRaw[(size_t)R * 256 + tid];
                    const float mean = wsum(yv) * (1.0f / 64.0f), d = yv - mean;
                    const float var = wsum(d * d) * (1.0f / 64.0f);
                    float yn = d * rsqrtf(var + 64e-5f) * lnw + lnb;
                    yn += rwBon[(size_t)R * 4 + (tid >> 6)] * bf2f(rwB[(size_t)R * 1280 + 512 + tid]);
                    y[(size_t)R * 1024 + 256 + tid] = f2bf(yn * bf2f(rwG[(size_t)R * 256 + tid]));
                }
                {
                    const float o = glRaw[(size_t)R * 256 + tid] * 0.17677669529663687f;
                    const float ms = wsum(o * o) * (1.0f / 64.0f);
                    const float on = o * rsqrtf(ms + 1e-6f) * gn;
                    const float rgv = bf2f(Z[(size_t)R * ZLD + ZC_GLA + 528 + tid]);
                    y[(size_t)R * 1024 + 768 + tid] = f2bf(on * rgv * sigmoidf_(rgv));
                }
            }
        }
        grid.sync();

        PH(10) { pg8::Gemm g{nb, winT + (size_t)GATE0 * 1024, M, 4096, 1024}; pg8::StaticOrder So; So.init(M, 4096, G, obid()); pg8::EpiGate E{gates, 4096, L.gate_b};
            pg8::gemm_phase<pg8::EpiGate, pg8::StaticOrder, true, true>(ldsL, g, So, E); }
        grid.sync();

        PH(11) {
            const int tid0 = otid(), half = tid0 >> 8, vt = tid0 & 255, bid = obid();
            bf16_t* lds = (bf16_t*)(dynlds + half * 40960);
            constexpr int nT = (M / 128) * 16;
            const int iters = (nT + 2 * G - 1) / (2 * G);
            for (int it = 0; it < iters; ++it) {
                int t = (it * G + bid) * 2 + half; const bool active = t < nT; if (!active) t = nT - 1;
                const int mt = t >> 4, nt = t & 15, m0 = mt * 128, n0 = nt * 64;
                f32x16 out[2][1]; acc_zero<1>(out);
                const int lane = vt & 63, wave = vt >> 6, wm = wave >> 1, wn = wave & 1, r = lane & 31, hh = lane >> 5;
                for (int n = 0; n < 4; ++n) {
                    f32x16 ab[2][1]; acc_zero<1>(ab);
                    gemm_tile<1>(ab, y + (size_t)m0 * 1024 + n * 256, 1024, brT + (size_t)(n * 1024 + n0) * 256, 256, 256, lds, vt);
                    const bf16_t* gp = gates + (size_t)(m0 + wm * 64 + 4 * hh) * 4096 + n * 1024 + n0 + wn * 32 + r;
#pragma unroll
                    for (int a = 0; a < 2; ++a)
#pragma unroll
                        for (int i = 0; i < 16; ++i) out[a][0][i] += bf2f(gp[(size_t)(a * 32 + (i & 3) + 8 * (i >> 2)) * 4096]) * ab[a][0][i];
                }
                if (active) epi_foreach<1>(out, m0, n0, vt, [&](int row, int col, float v) { merged[(size_t)row * 1024 + col] = f2bf(v); });
            }
        }
        grid.sync();

        PH(12) { pg8::Gemm g{merged, woutT, M, 1024, 1024}; pg8::StaticOrder So; So.init(M, 1024, G, obid()); pg8::EpiResid E{h, 0};
            pg8::gemm_phase<pg8::EpiResid, pg8::StaticOrder, true, true>(ldsL, g, So, E); }
        grid.sync();

        PH(13) phase_norm(0, p, h, p.in[25] + layer * 1024, nb);
        grid.sync();

        for (int hf = 0; hf < 2; ++hf) {
            PH(14) { pg8::Gemm g{nb + (size_t)hf * MH * 1024, finT, MH, 5632, 1024}; pg8::StaticOrder So; So.init(MH, 5632, G, obid()); pg8::EpiStoreBf16 E{au, 5632};
                pg8::gemm_phase<pg8::EpiStoreBf16, pg8::StaticOrder, true, true>(ldsL, g, So, E); }
            grid.sync();
            PH(15) {
                const long total = (long)MH * (DFF / 4); const int gtid = obid() * NTHR + otid();
                for (long u = gtid; u < total; u += gthreads) {
                    const int rl = (int)(u / (DFF / 4)), f = (int)(u % (DFF / 4)) * 4;
                    const int tok = (hf * MH + rl) % LP - PADF;
                    const bf16_t* a2p = au + (size_t)rl * 5632 + f;
                    float out4[4];
                    const float4 cb = *(const float4*)(L.conv_b + f), w0 = *(const float4*)(L.conv_w + f), w1 = *(const float4*)(L.conv_w + DFF + f), w2 = *(const float4*)(L.conv_w + 2 * DFF + f);
                    const float cbv[4] = {cb.x, cb.y, cb.z, cb.w}, w0v[4] = {w0.x, w0.y, w0.z, w0.w}, w1v[4] = {w1.x, w1.y, w1.z, w1.w}, w2v[4] = {w2.x, w2.y, w2.z, w2.w};
                    const uint2 c0 = *(const uint2*)a2p, uu = *(const uint2*)(a2p + DFF);
                    uint2 c1 = make_uint2(0u, 0u), c2 = make_uint2(0u, 0u);
                    if (tok >= 1) c1 = *(const uint2*)(a2p - 5632);
                    if (tok >= 2) c2 = *(const uint2*)(a2p - 2 * 5632);
                    const float a0v[4] = {__uint_as_float(c0.x << 16), __uint_as_float(c0.x & 0xffff0000u), __uint_as_float(c0.y << 16), __uint_as_float(c0.y & 0xffff0000u)};
                    const float a1v[4] = {__uint_as_float(c1.x << 16), __uint_as_float(c1.x & 0xffff0000u), __uint_as_float(c1.y << 16), __uint_as_float(c1.y & 0xffff0000u)};
                    const float a2v[4] = {__uint_as_float(c2.x << 16), __uint_as_float(c2.x & 0xffff0000u), __uint_as_float(c2.y << 16), __uint_as_float(c2.y & 0xffff0000u)};
                    const float uv[4] = {__uint_as_float(uu.x << 16), __uint_as_float(uu.x & 0xffff0000u), __uint_as_float(uu.y << 16), __uint_as_float(uu.y & 0xffff0000u)};
#pragma unroll
                    for (int e = 0; e < 4; ++e) { const float a = cbv[e] + w0v[e] * a2v[e] + w1v[e] * a1v[e] + w2v[e] * a0v[e]; out4[e] = a * sigmoidf_(a) * uv[e]; }
                    uint2 w; w.x = pack2(out4[0], out4[1]); w.y = pack2(out4[2], out4[3]);
                    *(uint2*)(act + (size_t)rl * DFF + f) = w;
                }
            }
            grid.sync();
            PH(16) { pg8::Gemm g{act, foutT, MH, 1024, DFF}; pg8::StaticOrder So; So.init(MH, 1024, G, obid()); pg8::EpiResid E{h, hf * MH};
                pg8::gemm_phase<pg8::EpiResid, pg8::StaticOrder, true, true>(ldsL, g, So, E); }
            grid.sync();
        }
    }
    PH(17) phase_norm(2, p, h, p.in[30], nb);
}

extern "C" void kernel_launch(void* const* d_in, const int* in_sizes, int n_in, void* d_out, int out_size, void* d_ws, size_t ws_size, hipStream_t stream) {
    static int grid_blocks = 0;
    if (!grid_blocks) {
        int dev = 0, cus = 0, per_cu = 0;
        (void)hipGetDevice(&dev);
        (void)hipDeviceGetAttribute(&cus, hipDeviceAttributeMultiprocessorCount, dev);
        if (hipFuncSetAttribute((const void*)mega, hipFuncAttributeMaxDynamicSharedMemorySize, DYN_LDS) != hipSuccess) fprintf(stderr, "hipFuncSetAttribute failed\n");
        (void)hipOccupancyMaxActiveBlocksPerMultiprocessor(&per_cu, mega, NTHR, DYN_LDS);
        if (per_cu != 1) fprintf(stderr, "note: occupancy query says %d blocks per CU; launching one per CU\n", per_cu);
        (void)hipGetLastError();
        grid_blocks = cus;
    }
    if (ws_size < WS_NEED) fprintf(stderr, "workspace too small: %zu < %zu\n", ws_size, (size_t)WS_NEED);
    Params p{};
    for (int i = 0; i < 31; ++i) p.in[i] = (const float*)d_in[i];
    p.out = (float*)d_out; p.ws = (char*)d_ws;
    (void)hipMemsetAsync(d_ws, 0, 1024, stream);
    void* args[] = {&p};
    hipError_t e = hipLaunchCooperativeKernel((void*)mega, dim3(grid_blocks), dim3(NTHR), args, DYN_LDS, stream);
    if (e != hipSuccess) fprintf(stderr, "cooperative launch failed: %s (grid %d)\n", hipGetErrorString(e), grid_blocks);
}
```

```cpp
#include <hip/hip_runtime.h>
#include <hip/hip_cooperative_groups.h>
#include <stdint.h>
#include <stdio.h>
namespace cg = cooperative_groups;

#define DI __device__ __forceinline__
typedef unsigned short bf16_t;
typedef short bf16x8 __attribute__((ext_vector_type(8)));
typedef short s16x4 __attribute__((ext_vector_type(4)));
typedef float f32x16 __attribute__((ext_vector_type(16)));

constexpr int D = 1024, NBATCH = 4, SEQ = 4096, LTOK = 4112, PADF = 112, LP = 4224, M = NBATCH * LP;
constexpr int ZLD = 3072;
constexpr int ZC_CQ = 0, ZC_CKV = 256, ZC_KR = 384, ZC_RW = 416, ZC_SB = 1440, ZC_GLA = 2208;
constexpr int INTOT = 7088, GATE0 = 2992, DFF = 2816, MH = M / 2;

constexpr size_t al256(size_t x) { return (x + 255) & ~(size_t)255; }
constexpr size_t OFF_CTR = 0;
constexpr size_t OFF_BAR = 1024;
constexpr size_t OFF_H = 16384;
constexpr size_t OFF_NB = OFF_H + (size_t)M * D * 4;
constexpr size_t OFF_Y = OFF_NB + (size_t)M * D * 2;
constexpr size_t OFF_W = OFF_Y + (size_t)M * D * 2;
constexpr size_t W_WIN = 0;
constexpr size_t W_UQ = W_WIN + (size_t)INTOT * 1024 * 2;
constexpr size_t W_UKV = W_UQ + (size_t)384 * 256 * 2;
constexpr size_t W_BR = W_UKV + (size_t)512 * 128 * 2;
constexpr size_t W_OUT = W_BR + (size_t)4 * 1024 * 256 * 2;
constexpr size_t W_FIN = W_OUT + (size_t)1024 * 1024 * 2;
constexpr size_t W_FOUT = W_FIN + (size_t)5632 * 1024 * 2;
constexpr size_t W_END = W_FOUT + (size_t)1024 * DFF * 2;
constexpr size_t OFF_S = al256(OFF_W + W_END);
constexpr size_t S_Z = 0;
constexpr size_t S_CQN = S_Z + (size_t)M * ZLD * 2;
constexpr size_t S_CKVN = S_CQN + (size_t)M * 256 * 2;
constexpr size_t S_QM = S_CKVN + (size_t)M * 128 * 2;
constexpr size_t S_KM = S_QM + (size_t)M * 384 * 2;
constexpr size_t S_VTM = S_KM + (size_t)M * 384 * 2;
constexpr size_t S_VTS = S_VTM + (size_t)16 * 64 * LP * 2;
constexpr size_t S_RWA = S_VTS + (size_t)16 * 64 * LP * 2;
constexpr size_t S_RWB = S_RWA + (size_t)M * 256 * 4;
constexpr size_t S_RWG = S_RWB + (size_t)M * 1280 * 2;
constexpr size_t S_RWBON = S_RWG + (size_t)M * 256 * 2;
constexpr size_t S_GLA = S_RWBON + (size_t)M * 4 * 4;
constexpr size_t S_RWRAW = S_GLA + (size_t)M * 128 * 4;
constexpr size_t S_GLRAW = S_RWRAW + (size_t)M * 256 * 4;
constexpr size_t S_END = S_GLRAW + (size_t)M * 256 * 4;
constexpr size_t S_GATES = 0;
constexpr size_t S_MERGED = S_GATES + (size_t)M * 4096 * 2;
static_assert(S_MERGED + (size_t)M * 1024 * 2 <= S_END, "merged must fit");
constexpr size_t S_AU = 0;
constexpr size_t S_ACT = S_AU + (size_t)MH * 5632 * 2;
constexpr size_t WS_NEED = OFF_S + S_END;

struct Params { const float* in[31]; float* out; char* ws; };
#ifndef PHMASK
#define PHMASK 0xffffffffu
#endif
#define PH(b) if constexpr ((PHMASK >> (b)) & 1u)
constexpr int NTHR = 512, DYN_LDS = 131072;
#ifndef REP2SEL
#define REP2SEL 15
#endif
#ifndef REPMASK
#define REPMASK 0u
#endif
#ifdef SYNC2
#define GSYNC() do { xcd_barrier(xbar); xcd_barrier(xbar); } while (0)
#else
#define GSYNC() do { if (first_sync) { grid.sync(); first_sync = false; } else xcd_barrier(xbar); } while (0)
#endif
#define REP(b) for (int rep_ = 0; rep_ < (((REPMASK >> (b)) & 1u) ? 2 : 1); ++rep_)

DI int otid() { int t = threadIdx.x; asm volatile("" : "+v"(t)); return t; }
DI int obid() { int t = blockIdx.x; asm volatile("" : "+s"(t)); return t; }
DI float bf2f(bf16_t v) { return __uint_as_float(((unsigned)v) << 16); }
DI bf16_t f2bf(float f) { unsigned u = __float_as_uint(f); u += 0x7fffu + ((u >> 16) & 1u); return (bf16_t)(u >> 16); }
DI unsigned pack2(float a, float b) { return (unsigned)f2bf(a) | ((unsigned)f2bf(b) << 16); }
DI float wsum(float x) { x += __shfl_xor(x, 32); x += __shfl_xor(x, 16); x += __shfl_xor(x, 8); x += __shfl_xor(x, 4); x += __shfl_xor(x, 2); x += __shfl_xor(x, 1); return x; }
template <int CTRL> DI float dppf(float x) { return __int_as_float(__builtin_amdgcn_update_dpp(0, __float_as_int(x), CTRL, 0xf, 0xf, true)); }
DI float red16(float x) { x += dppf<0xB1>(x); x += dppf<0x4E>(x); x += dppf<0x141>(x); x += dppf<0x140>(x); return x; }
DI float sigmoidf_(float x) { return 1.0f / (1.0f + __expf(-x)); }
DI float softplusf_(float x) { return fmaxf(x, 0.f) + __logf(1.0f + __expf(-fabsf(x))); }
DI float tanhf_(float x) { return 1.0f - 2.0f / (1.0f + __expf(2.0f * x)); }
DI void rope_sc(int tok, int i, float& s, float& c) {
    float fr = exp2f(-(float)i * (13.287712379549449f / 16.0f));
    float ang = (float)tok * fr;
    double rv = (double)ang * 0.15915494309189535;
    rv -= floor(rv);
    float f = (float)rv;
    s = __builtin_amdgcn_sinf(f); c = __builtin_amdgcn_cosf(f);
}
#define MFMA(a, b, c) __builtin_amdgcn_mfma_f32_32x32x16_bf16((a), (b), (c), 0, 0, 0)

namespace pg8 {
#define PG8_LAS __attribute__((address_space(3)))
typedef unsigned short bf16_t;
typedef short bf16x8 __attribute__((ext_vector_type(8)));
typedef float f32x4 __attribute__((ext_vector_type(4)));
typedef unsigned u32x4 __attribute__((ext_vector_type(4)));
constexpr int BM = 256, BK = 64, HALF = 128, HTB = HALF * BK * 2  , STAGE_BYTES = 8 * HTB, NXCD = 8, WGM = 8;

__host__ __device__ __forceinline__ int lds_byte(int r, int c) { const int st = (r >> 4) * 2 + (c >> 5), rr = r & 15, cc = c & 31, ob = rr * 64 + cc * 2; return st * 1024 + (ob ^ (((ob >> 9) & 1) << 5)); }
__host__ __device__ __forceinline__ void stage_rc(int b, int& R, int& C) { const int st = b / 1024, sb = b % 1024, swz = sb ^ (((sb >> 9) & 1) << 5); R = (st >> 1) * 16 + swz / 64; C = (st & 1) * 32 + (swz % 64) / 2; }
__host__ __device__ __forceinline__ int perm32(int rho) { const int n = rho >> 4, i = rho & 15; return 8 * (i >> 2) + 4 * n + (i & 3); }

struct Unit { int pm, pn; };
struct Gemm { const bf16_t* A; const bf16_t* Bt; int M, N, K; };

struct StaticOrder {
    int nM, nN, nwg, G, c;
    __host__ __device__ void init(int M, int N, int G_, int c_) { nM = M / BM; nN = N / BM; nwg = nM * nN; G = G_; c = c_; }
    __host__ __device__ bool next(int i, Unit& u) const {
        const long L = (long)i * G + c; if (L >= nwg) return false;
        int wgid = (int)L; { const int q = nwg / NXCD, r = nwg % NXCD, xcd = wgid % NXCD, off = wgid / NXCD; wgid = (xcd < r ? xcd * (q + 1) : r * (q + 1) + (xcd - r) * q) + off; }
        const int nig = WGM * nN, gid = wgid / nig, fm = gid * WGM, gsz = (nM - fm) < WGM ? (nM - fm) : WGM;
        u.pm = fm + ((wgid % nig) % gsz); u.pn = (wgid % nig) / gsz; return true;
    }
    __device__ __forceinline__ void a_ready(const Unit&) const {}
    __device__ __forceinline__ void done(const Unit&) const {}
};

__device__ __forceinline__ unsigned cvt_pk_bf16(float lo, float hi) { unsigned r; asm volatile("v_cvt_pk_bf16_f32 %0, %1, %2" : "=v"(r) : "v"(lo), "v"(hi)); return r; }
template <class Epi, class Sched, bool ALIGN_EPI = false, bool SP2 = false>
__device__ __forceinline__ void gemm_phase(PG8_LAS unsigned char* lds, const Gemm g, const Sched& S, const Epi& E) {
    const int tid = otid(), wid = __builtin_amdgcn_readfirstlane(tid >> 6), lane = tid & 63, wr = wid >> 2, wc = wid & 3, fr = lane & 15, fq = lane >> 4;
    const int K = g.K, nt = K / BK;
    unsigned voffA[2], voffB[2];
#pragma unroll
    for (int i = 0; i < 2; ++i) { int R, C; stage_rc(tid * 16 + i * 8192, R, C); const int Rb = Epi::PERM ? ((R & ~31) + perm32(R & 31)) : R;
        voffA[i] = (unsigned)(R * K + C) * 2u; voffB[i] = (unsigned)(Rb * K + C) * 2u; }
    const size_t kstep = (size_t)(BK * 2);
    const size_t hstep = (size_t)HALF * K * 2;
    const size_t tstep = 2 * hstep;
    const unsigned ldsw = (unsigned)wid * 1024u;
    const int aoff = lds_byte(wr * 64 + fr, fq * 8), boff = lds_byte(wc * 32 + fr, fq * 8);
#define PG8_SA(b, h) (((b) * 2 + (h)) * HTB)
#define PG8_SB(b, h) ((4 + (b) * 2 + (h)) * HTB)
#define PG8_STAGE(bufoff, gbase, voff) do { _Pragma("unroll") for (int _i = 0; _i < 2; ++_i) \
        __builtin_amdgcn_global_load_lds((const unsigned*)((const char*)(gbase) + (voff)[_i]), (PG8_LAS unsigned*)(lds + (bufoff) + ldsw + _i * 8192), 16, 0, 0); } while (0)
#define PG8_LDA(dst, b, h) do { _Pragma("unroll") for (int m = 0; m < 4; ++m) _Pragma("unroll") for (int k = 0; k < 2; ++k) dst[m][k] = *(const PG8_LAS bf16x8*)(lds + PG8_SA(b, h) + aoff + m * 2048 + k * 1024); } while (0)
#define PG8_LDB(dst, b, h) do { _Pragma("unroll") for (int n = 0; n < 2; ++n) _Pragma("unroll") for (int k = 0; k < 2; ++k) dst[n][k] = *(const PG8_LAS bf16x8*)(lds + PG8_SB(b, h) + boff + n * 2048 + k * 1024); } while (0)
#define PG8_MMA(ai, bj, At, Bt) do { __builtin_amdgcn_s_setprio(1); _Pragma("unroll") for (int m = 0; m < 4; ++m) _Pragma("unroll") for (int n = 0; n < 2; ++n) _Pragma("unroll") for (int k = 0; k < 2; ++k) \
        acc[ai][bj][m][n] = __builtin_amdgcn_mfma_f32_16x16x32_bf16(Bt[n][k], At[m][k], acc[ai][bj][m][n], 0, 0, 0); __builtin_amdgcn_s_setprio(0); } while (0)
#define PG8_WAIT_V(n) asm volatile("s_waitcnt vmcnt(" #n ")" ::: "memory")
#define PG8_WAIT_L(n) asm volatile("s_waitcnt lgkmcnt(" #n ")" ::: "memory")
#define PG8_BAR __builtin_amdgcn_s_barrier()
#define PG8_SCHED __builtin_amdgcn_sched_barrier(0)
    Unit cur, nxt; int ui = 0;
    if (!S.next(0, cur)) return;
    f32x4 acc[2][2][4][2];
#pragma unroll
    for (int a = 0; a < 2; ++a)
#pragma unroll
        for (int b = 0; b < 2; ++b)
#pragma unroll
            for (int m = 0; m < 4; ++m)
#pragma unroll
                for (int n = 0; n < 2; ++n) acc[a][b][m][n] = (f32x4){0.f, 0.f, 0.f, 0.f};
    bf16x8 At[4][2], B0[2][2], B1[2][2];
    const char* cA = (const char*)g.A + (size_t)cur.pm * tstep; const char* cB = (const char*)g.Bt + (size_t)cur.pn * tstep;
    S.a_ready(cur);
    if constexpr (SP2) {
        PG8_STAGE(PG8_SB(0, 0), cB, voffB); PG8_STAGE(PG8_SB(0, 1), cB + hstep, voffB); PG8_STAGE(PG8_SA(0, 0), cA, voffA); PG8_STAGE(PG8_SA(0, 1), cA + hstep, voffA);
        if (wr == 1) PG8_BAR;
        PG8_WAIT_V(2); PG8_BAR;
        PG8_STAGE(PG8_SB(1, 0), cB + kstep, voffB); PG8_STAGE(PG8_SA(1, 0), cA + kstep, voffA); PG8_STAGE(PG8_SB(1, 1), cB + hstep + kstep, voffB);
        PG8_WAIT_V(6); PG8_BAR;
    } else {
        PG8_STAGE(PG8_SB(0, 0), cB, voffB); PG8_STAGE(PG8_SA(0, 0), cA, voffA); PG8_STAGE(PG8_SB(0, 1), cB + hstep, voffB); PG8_STAGE(PG8_SA(0, 1), cA + hstep, voffA);
        if (wr == 1) PG8_BAR;
        PG8_WAIT_V(4); PG8_BAR;
        PG8_STAGE(PG8_SB(1, 0), cB + kstep, voffB); PG8_STAGE(PG8_SA(1, 0), cA + kstep, voffA); PG8_STAGE(PG8_SB(1, 1), cB + hstep + kstep, voffB);
        PG8_WAIT_V(6); PG8_BAR;
    }
    for (;;) {
        const bool has_next = S.next(ui + 1, nxt);
        const char* nA = has_next ? (const char*)g.A + (size_t)nxt.pm * tstep : cA; const char* nB = has_next ? (const char*)g.Bt + (size_t)nxt.pn * tstep : cB;
        for (int t = 0; t < nt; t += 2) {
            const bool last = (t == nt - 2);
            const char* a1 = cA + (size_t)(t + 1) * kstep;
            const char* a2 = last ? nA : cA + (size_t)(t + 2) * kstep; const char* b2 = last ? nB : cB + (size_t)(t + 2) * kstep;
            const char* a3 = a2 + kstep; const char* b3 = b2 + kstep;
            if (last && has_next) S.a_ready(nxt);
            if constexpr (SP2) {
            PG8_LDB(B0, 0, 0); PG8_LDB(B1, 0, 1); PG8_SCHED; PG8_LDA(At, 0, 0); PG8_STAGE(PG8_SA(1, 1), a1 + hstep, voffA);
            PG8_WAIT_V(8); PG8_WAIT_L(0); PG8_BAR; PG8_MMA(0, 0, At, B0); PG8_MMA(0, 1, At, B1); PG8_BAR; PG8_SCHED;
            PG8_LDA(At, 0, 1); PG8_STAGE(PG8_SB(0, 0), b2, voffB); PG8_STAGE(PG8_SB(0, 1), b2 + hstep, voffB); PG8_STAGE(PG8_SA(0, 0), a2, voffA);
            PG8_WAIT_V(8); PG8_WAIT_L(0); PG8_BAR; PG8_MMA(1, 0, At, B0); PG8_MMA(1, 1, At, B1); PG8_BAR; PG8_SCHED;
            PG8_LDB(B0, 1, 0); PG8_LDB(B1, 1, 1); PG8_SCHED; PG8_LDA(At, 1, 0); PG8_STAGE(PG8_SA(0, 1), a2 + hstep, voffA);
            PG8_WAIT_V(8); PG8_WAIT_L(0); PG8_BAR; PG8_MMA(0, 0, At, B0); PG8_MMA(0, 1, At, B1); PG8_BAR; PG8_SCHED;
            PG8_LDA(At, 1, 1); PG8_STAGE(PG8_SB(1, 0), b3, voffB); PG8_STAGE(PG8_SB(1, 1), b3 + hstep, voffB); PG8_STAGE(PG8_SA(1, 0), a3, voffA);
            PG8_WAIT_V(8); PG8_WAIT_L(0); PG8_BAR; PG8_MMA(1, 0, At, B0); PG8_MMA(1, 1, At, B1); PG8_BAR; PG8_SCHED;
            } else {
            PG8_LDB(B0, 0, 0); PG8_SCHED; PG8_LDA(At, 0, 0); PG8_STAGE(PG8_SA(1, 1), a1 + hstep, voffA);
            PG8_WAIT_L(8); PG8_BAR; PG8_WAIT_L(0); PG8_MMA(0, 0, At, B0); PG8_BAR; PG8_SCHED;
            PG8_LDB(B1, 0, 1); PG8_STAGE(PG8_SB(0, 0), b2, voffB);
            PG8_BAR; PG8_WAIT_L(0); PG8_MMA(0, 1, At, B1); PG8_BAR;
            PG8_LDA(At, 0, 1); PG8_STAGE(PG8_SA(0, 0), a2, voffA);
            PG8_BAR; PG8_WAIT_L(0); PG8_MMA(1, 0, At, B0); PG8_BAR; PG8_SCHED;
            PG8_STAGE(PG8_SB(0, 1), b2 + hstep, voffB);
            PG8_WAIT_V(6); PG8_BAR; PG8_MMA(1, 1, At, B1); PG8_BAR;
            PG8_LDB(B0, 1, 0); PG8_SCHED; PG8_LDA(At, 1, 0); PG8_STAGE(PG8_SA(0, 1), a2 + hstep, voffA);
            PG8_WAIT_L(8); PG8_BAR; PG8_WAIT_L(0); PG8_MMA(0, 0, At, B0); PG8_BAR; PG8_SCHED;
            PG8_LDB(B1, 1, 1); PG8_STAGE(PG8_SB(1, 0), b3, voffB);
            PG8_BAR; PG8_WAIT_L(0); PG8_MMA(0, 1, At, B1); PG8_BAR;
            PG8_LDA(At, 1, 1); PG8_STAGE(PG8_SA(1, 0), a3, voffA);
            PG8_BAR; PG8_WAIT_L(0); PG8_MMA(1, 0, At, B0); PG8_BAR; PG8_SCHED;
            PG8_STAGE(PG8_SB(1, 1), b3 + hstep, voffB);
            PG8_WAIT_V(6); PG8_BAR; PG8_MMA(1, 1, At, B1); PG8_BAR;
            }
        }
        if constexpr (ALIGN_EPI) { if (wr == 0) PG8_BAR; }
        if constexpr (!Epi::AFTER_DRAIN) { E(acc, cur, wr, wc, fr, fq); S.done(cur); }
        if (!has_next) break;
#pragma unroll
        for (int a = 0; a < 2; ++a)
#pragma unroll
            for (int b = 0; b < 2; ++b)
#pragma unroll
                for (int m = 0; m < 4; ++m)
#pragma unroll
                    for (int n = 0; n < 2; ++n) acc[a][b][m][n] = (f32x4){0.f, 0.f, 0.f, 0.f};
        cur = nxt; cA = nA; cB = nB; ++ui;
        if constexpr (ALIGN_EPI) { if (wr == 1) PG8_BAR; }
    }
    PG8_WAIT_V(0);
    if constexpr (!ALIGN_EPI) { if (wr == 0) PG8_BAR; }
    PG8_BAR;
    if constexpr (Epi::AFTER_DRAIN) { E.fused(acc, cur, wr, wc, fr, fq, lds, wid, lane); S.done(cur); }
#undef PG8_SA
#undef PG8_SB
#undef PG8_STAGE
#undef PG8_LDA
#undef PG8_LDB
#undef PG8_MMA
#undef PG8_WAIT_V
#undef PG8_WAIT_L
#undef PG8_BAR
#undef PG8_SCHED
}
}

template <int NT>
DI void gemm_tile(f32x16 (&acc)[2][NT], const bf16_t* __restrict__ A, int lda, const bf16_t* __restrict__ Bt, int ldb, int K, bf16_t* lds, int vt) {
    constexpr int BN = 64 * NT;
    bf16_t* As = lds;
    bf16_t* Bs = lds + 2 * 128 * 40;
    const int lane = vt & 63, wave = vt >> 6, wm = wave >> 1, wn = wave & 1, r = lane & 31, hh = lane >> 5;
    uint4 ra[2], rb[NT];
    const int row0 = vt >> 2, kc = vt & 3;
    auto gload = [&](int k0) {
#pragma unroll
        for (int i = 0; i < 2; ++i) ra[i] = *(const uint4*)(A + (size_t)(row0 + 64 * i) * lda + k0 + kc * 8);
#pragma unroll
        for (int i = 0; i < NT; ++i) rb[i] = *(const uint4*)(Bt + (size_t)(row0 + 64 * i) * ldb + k0 + kc * 8);
    };
    auto lstore = [&](int buf) {
#pragma unroll
        for (int i = 0; i < 2; ++i) *(uint4*)(As + buf * 5120 + (row0 + 64 * i) * 40 + kc * 8) = ra[i];
#pragma unroll
        for (int i = 0; i < NT; ++i) *(uint4*)(Bs + buf * BN * 40 + (row0 + 64 * i) * 40 + kc * 8) = rb[i];
    };
    gload(0); lstore(0); __syncthreads();
    const int nk = K >> 5;
    for (int kt = 0; kt < nk; ++kt) {
        const int cur = kt & 1;
        if (kt + 1 < nk) gload((kt + 1) << 5);
#pragma unroll
        for (int s = 0; s < 2; ++s) {
            bf16x8 af[2], bfr[NT];
#pragma unroll
            for (int mt = 0; mt < 2; ++mt) af[mt] = *(const bf16x8*)(As + cur * 5120 + (wm * 64 + mt * 32 + r) * 40 + s * 16 + hh * 8);
#pragma unroll
            for (int nt = 0; nt < NT; ++nt) bfr[nt] = *(const bf16x8*)(Bs + cur * BN * 40 + (wn * 32 * NT + nt * 32 + r) * 40 + s * 16 + hh * 8);
#pragma unroll
            for (int mt = 0; mt < 2; ++mt)
#pragma unroll
                for (int nt = 0; nt < NT; ++nt) acc[mt][nt] = MFMA(af[mt], bfr[nt], acc[mt][nt]);
        }
        if (kt + 1 < nk) lstore(cur ^ 1);
        __syncthreads();
    }
}
template <int NT> DI void acc_zero(f32x16 (&acc)[2][NT]) {
#pragma unroll
    for (int a = 0; a < 2; ++a)
#pragma unroll
        for (int b = 0; b < NT; ++b)
#pragma unroll
            for (int i = 0; i < 16; ++i) acc[a][b][i] = 0.f;
}
template <int NT, class F> DI void epi_foreach(f32x16 (&acc)[2][NT], int m0, int n0, int vt, F f) {
    const int lane = vt & 63, wave = vt >> 6, wm = wave >> 1, wn = wave & 1, r = lane & 31, hh = lane >> 5;
#pragma unroll
    for (int mt = 0; mt < 2; ++mt)
#pragma unroll
        for (int nt = 0; nt < NT; ++nt)
#pragma unroll
            for (int i = 0; i < 16; ++i) f(m0 + wm * 64 + mt * 32 + (i & 3) + 8 * (i >> 2) + 4 * hh, n0 + wn * 32 * NT + nt * 32 + r, acc[mt][nt][i]);
}
template <int NT, class Epi>
DI void phase_gemm_small(const bf16_t* A, int lda, const bf16_t* Bt, int ldb, int Mrows, int N, int K, unsigned char* ldsraw, Epi epi) {
    constexpr int BN = 64 * NT;
    const int tid = otid(), half = tid >> 8, vt = tid & 255, G = gridDim.x, bid = obid();
    bf16_t* lds = (bf16_t*)(ldsraw + half * 40960);
    const int nN = N / BN, nT = (Mrows / 128) * nN, iters = (nT + 2 * G - 1) / (2 * G);
    for (int it = 0; it < iters; ++it) {
        int t = (it * G + bid) * 2 + half; const bool active = t < nT; if (!active) t = nT - 1;
        const int mt = t / nN, nt = t % nN;
        f32x16 acc[2][NT]; acc_zero<NT>(acc);
        gemm_tile<NT>(acc, A + (size_t)mt * 128 * lda, lda, Bt + (size_t)nt * BN * ldb, ldb, K, lds, vt);
        if (active) epi_foreach<NT>(acc, mt * 128, nt * BN, vt, epi);
    }
}

namespace pg8 {
struct EpiStoreBf16 {
    static constexpr bool PERM = true, AFTER_DRAIN = false;
    bf16_t* O; int ldc;
    __device__ __forceinline__ void operator()(const f32x4 (&acc)[2][2][4][2], const Unit& u, int wr, int wc, int fr, int fq) const {
        const int row0 = u.pm * BM + wr * 64 + fr, col0 = u.pn * BM + wc * 32 + 8 * fq;
#pragma unroll
        for (int ai = 0; ai < 2; ++ai)
#pragma unroll
            for (int m = 0; m < 4; ++m) { bf16_t* rowp = O + (size_t)(row0 + ai * HALF + m * 16) * ldc + col0;
#pragma unroll
                for (int bj = 0; bj < 2; ++bj) { const f32x4 v0 = acc[ai][bj][m][0], v1 = acc[ai][bj][m][1];
                    u32x4 w; w.x = cvt_pk_bf16(v0[0], v0[1]); w.y = cvt_pk_bf16(v0[2], v0[3]); w.z = cvt_pk_bf16(v1[0], v1[1]); w.w = cvt_pk_bf16(v1[2], v1[3]);
                    *(u32x4*)(rowp + bj * HALF) = w; } }
    }
};
struct EpiGate {
    static constexpr bool PERM = true, AFTER_DRAIN = false;
    bf16_t* O; int ldc; const float* bias;
    __device__ __forceinline__ void operator()(const f32x4 (&acc)[2][2][4][2], const Unit& u, int wr, int wc, int fr, int fq) const {
        const int row0 = u.pm * BM + wr * 64 + fr, col0 = u.pn * BM + wc * 32 + 8 * fq;
        f32x4 bv[2][2];
#pragma unroll
        for (int bj = 0; bj < 2; ++bj)
#pragma unroll
            for (int n = 0; n < 2; ++n) bv[bj][n] = *(const f32x4*)(bias + col0 + bj * HALF + 4 * n);
#pragma unroll
        for (int ai = 0; ai < 2; ++ai)
#pragma unroll
            for (int m = 0; m < 4; ++m) { bf16_t* rowp = O + (size_t)(row0 + ai * HALF + m * 16) * ldc + col0;
#pragma unroll
                for (int bj = 0; bj < 2; ++bj) { f32x4 v0 = acc[ai][bj][m][0] + bv[bj][0], v1 = acc[ai][bj][m][1] + bv[bj][1];
#pragma unroll
                    for (int e = 0; e < 4; ++e) { v0[e] = 1.0f / (1.0f + __expf(-v0[e])); v1[e] = 1.0f / (1.0f + __expf(-v1[e])); }
                    u32x4 w; w.x = cvt_pk_bf16(v0[0], v0[1]); w.y = cvt_pk_bf16(v0[2], v0[3]); w.z = cvt_pk_bf16(v1[0], v1[1]); w.w = cvt_pk_bf16(v1[2], v1[3]);
                    *(u32x4*)(rowp + bj * HALF) = w; } }
    }
};
struct EpiResid {
    static constexpr bool PERM = true, AFTER_DRAIN = false;
    float* h; int row_off; float scale;
    __device__ __forceinline__ void operator()(const f32x4 (&acc)[2][2][4][2], const Unit& u, int wr, int wc, int fr, int fq) const {
        const int row0 = row_off + u.pm * BM + wr * 64 + fr, col0 = u.pn * BM + wc * 32 + 8 * fq;
#pragma unroll
        for (int ai = 0; ai < 2; ++ai)
#pragma unroll
            for (int m = 0; m < 4; ++m) { const int R = row0 + ai * HALF + m * 16;
                if (R % LP >= PADF) { float* rowp = h + (size_t)R * 1024 + col0;
#pragma unroll
                    for (int bj = 0; bj < 2; ++bj) { f32x4* p0 = (f32x4*)(rowp + bj * HALF); f32x4* p1 = p0 + 1;
                        const f32x4 o0 = *p0, o1 = *p1; *p0 = o0 + acc[ai][bj][m][0] * scale; *p1 = o1 + acc[ai][bj][m][1] * scale; } } }
    }
};
}
#define XB_TMO      128
#define XB_XCNT(j)  (256  + 64 * (j))
#define XB_XSUB(j)  (1280 + 64 * (j))
#define XB_XGEN(j)  (2304 + 64 * (j))
#define XB_TOP      3328
#define XB_TOPGEN   3392
#define XCD_BAR_WORDS 3456
#define XB_SPIN_CAP (1u << 18)

__device__ __forceinline__ unsigned xb_ld(unsigned* p)              { return __hip_atomic_load(p, __ATOMIC_RELAXED, __HIP_MEMORY_SCOPE_AGENT); }
__device__ __forceinline__ unsigned xb_add(unsigned* p, unsigned v) { return __hip_atomic_fetch_add(p, v, __ATOMIC_RELAXED, __HIP_MEMORY_SCOPE_AGENT); }
__device__ __forceinline__ unsigned xb_xcc_id() { return (unsigned)__builtin_amdgcn_s_getreg((3 << 11) | 20) & 0xFu; }
#define XB_SPIN(cond, bar) do { unsigned _sp = 0; while (cond) { __builtin_amdgcn_s_sleep(1); \
    if ((++_sp & 255u) == 0u) { if (xb_ld(&(bar)[XB_TMO])) break; if (_sp > XB_SPIN_CAP) { atomicAdd(&(bar)[XB_TMO], 1u); break; } } } } while (0)

struct XcdBarrier {
    unsigned* bar; unsigned x;
    volatile PG8_LAS unsigned* st;
};

__device__ __forceinline__ XcdBarrier xcd_barrier_post(unsigned* bar, volatile PG8_LAS unsigned* st) {
    XcdBarrier b; b.bar = bar; b.x = xb_xcc_id(); b.st = st;
    if (threadIdx.x == 0) (void)xb_add(&bar[XB_XCNT(b.x)], 1u);
    return b;
}
__device__ __forceinline__ void xcd_barrier_complete(unsigned* bar, unsigned x, unsigned& nloc, unsigned& nx) {
    const unsigned G = gridDim.x * gridDim.y * gridDim.z;
    unsigned sum, cnt, mine, sp = 0u;
    for (;;) {
        sum = 0u; cnt = 0u; mine = 0u;
#pragma unroll
        for (unsigned j = 0; j < 16; ++j) { const unsigned c = xb_ld(&bar[XB_XCNT(j)]); sum += c; cnt += (c > 0u) ? 1u : 0u; mine = (j == x) ? c : mine; }
        if (sum == G) break;
        __builtin_amdgcn_s_sleep(1);
        if ((++sp & 255u) == 0u) { if (xb_ld(&bar[XB_TMO])) break; if (sp > XB_SPIN_CAP) { atomicAdd(&bar[XB_TMO], 1u); break; } }
    }
    nloc = mine > 0u ? mine : 1u; nx = cnt > 0u ? cnt : 1u;
}

__device__ __forceinline__ void xcd_barrier(const XcdBarrier& b) {
    asm volatile("s_waitcnt vmcnt(0)" ::: "memory");
    __syncthreads();
    if (threadIdx.x == 0) {
        unsigned* bar = b.bar;
        __builtin_amdgcn_s_waitcnt(0);
        unsigned nloc = b.st[0], nx = b.st[1];
        if (nloc == 0u) { xcd_barrier_complete(bar, b.x, nloc, nx); b.st[0] = nloc; b.st[1] = nx; }
        const unsigned old = xb_add(&bar[XB_XSUB(b.x)], 1u);
        const unsigned gen = old / nloc;
        if (old + 1u == (gen + 1u) * nloc) {
            __builtin_amdgcn_fence(__ATOMIC_RELEASE, "agent");
            asm volatile("s_waitcnt vmcnt(0)" ::: "memory");
            const unsigned og = xb_add(&bar[XB_TOP], 1u);
            const unsigned tg = og / nx;
            if (og + 1u == (tg + 1u) * nx) xb_add(&bar[XB_TOPGEN], 1u);
            else XB_SPIN(xb_ld(&bar[XB_TOPGEN]) == tg, bar);
            __builtin_amdgcn_fence(__ATOMIC_ACQUIRE, "agent");
            xb_add(&bar[XB_XGEN(b.x)], 1u);
            asm volatile("s_waitcnt vmcnt(0)" ::: "memory");
        } else {
            XB_SPIN(xb_ld(&bar[XB_XGEN(b.x)]) == gen, bar);
            __builtin_amdgcn_fence(__ATOMIC_ACQUIRE, "agent");
            asm volatile("s_waitcnt vmcnt(0)" ::: "memory");
        }
    }
    __syncthreads();
}

DI void convT(const float* __restrict__ W, int K, int N, bf16_t* __restrict__ Wt, int gtid, int gthreads) {
    const int K8 = K >> 3; const long total = (long)N * K8;
    for (long u = gtid; u < total; u += gthreads) {
        const int n = (int)(u % N), k8 = (int)(u / N);
        const float* src = W + (size_t)(k8 * 8) * N + n;
        float v[8];
#pragma unroll
        for (int j = 0; j < 8; ++j) v[j] = src[(size_t)j * N];
        uint4 o; o.x = pack2(v[0], v[1]); o.y = pack2(v[2], v[3]); o.z = pack2(v[4], v[5]); o.w = pack2(v[6], v[7]);
        *(uint4*)(Wt + (size_t)n * K + k8 * 8) = o;
    }
}

DI void phase_norm(int mode, const Params& p, float* h, const float* __restrict__ g, bf16_t* nb) {
    const int lane = otid() & 63, wv = otid() >> 6;
    for (int R = obid() * 8 + wv; R < M; R += gridDim.x * 8) {
        const int b = R / LP, pos = R % LP;
        const float* src = h + (size_t)R * D; bool zero = false;
        if (mode == 1) { if (pos < PADF) zero = true; else if (pos < 128) src = p.in[1] + (size_t)(pos - PADF) * D; else src = p.in[0] + ((size_t)b * SEQ + pos - 128) * D; }
        if (mode == 2 && pos < 128) continue;
        float4 v[4]; float ss = 0.f;
#pragma unroll
        for (int i = 0; i < 4; ++i) {
            v[i] = zero ? make_float4(0.f, 0.f, 0.f, 0.f) : *(const float4*)(src + i * 256 + lane * 4);
            ss += v[i].x * v[i].x + v[i].y * v[i].y + v[i].z * v[i].z + v[i].w * v[i].w;
        }
        ss = wsum(ss);
        const float rs = rsqrtf(ss * (1.0f / 1024.0f) + 1e-6f);
#pragma unroll
        for (int i = 0; i < 4; ++i) {
            const float4 gg = *(const float4*)(g + i * 256 + lane * 4);
            float4 o; o.x = v[i].x * rs * gg.x; o.y = v[i].y * rs * gg.y; o.z = v[i].z * rs * gg.z; o.w = v[i].w * rs * gg.w;
            if (mode == 2) *(float4*)(p.out + ((size_t)b * SEQ + pos - 128) * D + i * 256 + lane * 4) = o;
            else {
                if (mode == 1) *(float4*)(h + (size_t)R * D + i * 256 + lane * 4) = v[i];
                uint2 w; w.x = pack2(o.x, o.y); w.y = pack2(o.z, o.w);
                *(uint2*)(nb + (size_t)R * D + i * 256 + lane * 4) = w;
            }
        }
    }
}

struct LayerW {
    const float *q_norm, *kv_norm, *mu, *w0, *w2, *a0, *a2, *g2, *k_k, *k_a, *r_k, *ln_w, *ln_b, *gla_a2, *gla_a_b, *gla_norm, *gate_b, *conv_w, *conv_b;
};
constexpr int TB = 8;
DI void phase_prep(const LayerW& L, char* S, float* zin0) {
    const bf16_t* Z = (const bf16_t*)(S + S_Z);
    bf16_t* cqn = (bf16_t*)(S + S_CQN); bf16_t* ckvn = (bf16_t*)(S + S_CKVN); bf16_t* Km = (bf16_t*)(S + S_KM);
    bf16_t* VTs = (bf16_t*)(S + S_VTS); float* rwA = (float*)(S + S_RWA); bf16_t* rwB = (bf16_t*)(S + S_RWB);
    bf16_t* rwG = (bf16_t*)(S + S_RWG); float* rwBon = (float*)(S + S_RWBON); float* glA = (float*)(S + S_GLA);
    const int tid0 = otid(), half = tid0 >> 8, tid = tid0 & 255, lane = tid & 63, wv = tid >> 6, G = gridDim.x, bid = obid();
    float* zin = zin0 + half * TB * 256;
    constexpr int NG = M / TB;
    const int iters = (NG + 2 * G - 1) / (2 * G);
    for (int it = 0; it < iters; ++it) {
        const int grp = (it * G + bid) * 2 + half; const bool active = grp < NG;
        const int R0 = (active ? grp : 0) * TB, b = R0 / LP, pos0 = R0 % LP;
        {
            const int ch = 768 + tid; const float mu = L.mu[ch];
            for (int i = 0; i < TB; ++i) {
                const int R = R0 + i, tok = pos0 + i - PADF;
                const float zc = bf2f(Z[(size_t)R * ZLD + ZC_RW + ch]);
                const float zp = (tok > 0) ? bf2f(Z[(size_t)(R - 1) * ZLD + ZC_RW + ch]) : 0.f;
                const float zs = zc + (zp - zc) * mu;
                zin[i * 256 + tid] = tid < 64 ? tanhf_(zs) : (tid < 128 ? zs : sigmoidf_(zs));
            }
        }
        __syncthreads();
        float aw[TB], aa[TB], ag[TB];
#pragma unroll
        for (int i = 0; i < TB; ++i) { aw[i] = 0.f; aa[i] = 0.f; ag[i] = 0.f; }
        for (int j = 0; j < 64; j += 4) {
            float w2v[4], a2v[4];
#pragma unroll
            for (int q = 0; q < 4; ++q) { w2v[q] = L.w2[(j + q) * 256 + tid]; a2v[q] = L.a2[(j + q) * 256 + tid]; }
#pragma unroll
            for (int tk = 0; tk < TB; ++tk) {
                const float4 zw = *(const float4*)(zin + tk * 256 + j);
                const float4 za = *(const float4*)(zin + tk * 256 + 64 + j);
                aw[tk] += zw.x * w2v[0] + zw.y * w2v[1] + zw.z * w2v[2] + zw.w * w2v[3];
                aa[tk] += za.x * a2v[0] + za.y * a2v[1] + za.z * a2v[2] + za.w * a2v[3];
            }
        }
        for (int j = 0; j < 128; j += 4) {
            float g2v[4];
#pragma unroll
            for (int q = 0; q < 4; ++q) g2v[q] = L.g2[(j + q) * 256 + tid];
#pragma unroll
            for (int tk = 0; tk < TB; ++tk) {
                const float4 zg = *(const float4*)(zin + tk * 256 + 128 + j);
                ag[tk] += zg.x * g2v[0] + zg.y * g2v[1] + zg.z * g2v[2] + zg.w * g2v[3];
            }
        }
        {
            const float mur = L.mu[tid], muk = L.mu[256 + tid], muv = L.mu[512 + tid];
            const float w0 = L.w0[tid], a0 = L.a0[tid], kkc = L.k_k[tid], kac = L.k_a[tid], rkc = L.r_k[tid];
#pragma unroll
            for (int tk = 0; tk < TB; ++tk) {
                const int R = R0 + tk, tok = pos0 + tk - PADF;
                const bf16_t* zr = Z + (size_t)R * ZLD + ZC_RW;
                float rc = bf2f(zr[tid]), kcur = bf2f(zr[256 + tid]), vc = bf2f(zr[512 + tid]);
                float rp = 0.f, kp = 0.f, vp = 0.f;
                if (tok > 0) { const bf16_t* zq = zr - ZLD; rp = bf2f(zq[tid]); kp = bf2f(zq[256 + tid]); vp = bf2f(zq[512 + tid]); }
                const float r = rc + (rp - rc) * mur, k = kcur + (kp - kcur) * muk, v = vc + (vp - vc) * muv;
                const float wv_ = -softplusf_(-(w0 + aw[tk])) - 0.5f;
                const float decay = __expf(-__expf(wv_));
                const float a = sigmoidf_(a0 + aa[tk]);
                const float kkr = k * kkc;
                const float nrm = sqrtf(wsum(kkr * kkr));
                const float kk = kkr / fmaxf(nrm, 1e-12f);
                const float k2 = k * (1.0f + (a - 1.0f) * kac);
                const float bon = wsum(r * k2 * rkc);
                rwA[(size_t)R * 256 + tid] = decay;
                bf16_t* o = rwB + (size_t)R * 1280 + tid;
                o[0] = f2bf(r); o[256] = f2bf(k2); o[512] = f2bf(v); o[768] = f2bf(kk); o[1024] = f2bf(kk * a);
                rwG[(size_t)R * 256 + tid] = f2bf(ag[tk]);
                if (lane == 0) rwBon[(size_t)R * 4 + wv] = bon;
            }
        }
        for (int q = 0; q < TB / 4; ++q) {
            const int R = R0 + wv * (TB / 4) + q, tok = pos0 + wv * (TB / 4) + q - PADF;
            const bf16_t* zr = Z + (size_t)R * ZLD;
            {
                const uint2 raw = *(const uint2*)(zr + ZC_CQ + lane * 4);
                const float x0 = __uint_as_float(raw.x << 16), x1 = __uint_as_float(raw.x & 0xffff0000u), x2 = __uint_as_float(raw.y << 16), x3 = __uint_as_float(raw.y & 0xffff0000u);
                const float ss = wsum(x0 * x0 + x1 * x1 + x2 * x2 + x3 * x3);
                const float rs = rsqrtf(ss * (1.0f / 256.0f) + 1e-6f);
                const float4 gq = *(const float4*)(L.q_norm + lane * 4);
                uint2 w; w.x = pack2(x0 * rs * gq.x, x1 * rs * gq.y); w.y = pack2(x2 * rs * gq.z, x3 * rs * gq.w);
                *(uint2*)(cqn + (size_t)R * 256 + lane * 4) = w;
            }
            {
                const unsigned raw = *(const unsigned*)(zr + ZC_CKV + lane * 2);
                const float x0 = __uint_as_float(raw << 16), x1 = __uint_as_float(raw & 0xffff0000u);
                const float ss = wsum(x0 * x0 + x1 * x1);
                const float rs = rsqrtf(ss * (1.0f / 128.0f) + 1e-6f);
                *(unsigned*)(ckvn + (size_t)R * 128 + lane * 2) = pack2(x0 * rs * L.kv_norm[lane * 2], x1 * rs * L.kv_norm[lane * 2 + 1]);
            }
            if (lane < 16) {
                const float x1 = bf2f(zr[ZC_KR + lane]), x2 = bf2f(zr[ZC_KR + 16 + lane]);
                float sn, cs; rope_sc(tok, lane, sn, cs);
                const bf16_t o1 = f2bf(x1 * cs - x2 * sn), o2 = f2bf(x1 * sn + x2 * cs);
#pragma unroll
                for (int hd = 0; hd < 4; ++hd) { Km[(size_t)R * 384 + hd * 96 + 64 + lane] = o1; Km[(size_t)R * 384 + hd * 96 + 80 + lane] = o2; }
            }
        }
        for (int i = 0; i < TB / 2; ++i) {
            const int idx = tid + 256 * i, tk = idx >> 7, c = idx & 127, R = R0 + tk;
            const bf16_t* al = Z + (size_t)R * ZLD + ZC_GLA + 512;
            float x = L.gla_a_b[c];
#pragma unroll
            for (int j = 0; j < 16; ++j) x += bf2f(al[j]) * L.gla_a2[j * 128 + c];
            const float ls = fminf(x, 0.f) - __logf(1.0f + __expf(-fabsf(x)));
            glA[(size_t)R * 128 + c] = __expf(ls * (1.0f / 16.0f));
        }
        {
            unsigned pk[4];
#pragma unroll
            for (int tk = 0; tk < TB; tk += 2) {
                const unsigned lo = Z[(size_t)(R0 + tk) * ZLD + ZC_SB + 512 + tid], hi = Z[(size_t)(R0 + tk + 1) * ZLD + ZC_SB + 512 + tid];
                pk[tk >> 1] = lo | (hi << 16);
            }
            bf16_t* dst = VTs + ((size_t)((b * 4 + (tid >> 6)) * 64 + (tid & 63))) * LP + pos0;
            *(uint4*)dst = make_uint4(pk[0], pk[1], pk[2], pk[3]);
        }
        __syncthreads();
    }
}

template <bool SB>
DI void attn_item(int bh, int qblk, const bf16_t* __restrict__ Qb, const bf16_t* __restrict__ Kb, int stride, const bf16_t* __restrict__ VT, bf16_t* __restrict__ y, int ycol0) {
    constexpr int KS = SB ? 4 : 6, HD = SB ? 64 : 96;
    const float scale = SB ? 0.125f : 0.10206207261596575f;
    const int lane = otid() & 63, wave = otid() >> 6, r = lane & 31, hh = lane >> 5;
    const int b = bh >> 2, h = bh & 3;
    const int qb32 = qblk * 8 + wave, qpos = qb32 * 32 + r;
    if (qb32 >= LP / 32) return;
    const bf16_t* Qrow = Qb + (size_t)(b * LP + qpos) * stride + h * HD;
    bf16x8 qf[KS];
#pragma unroll
    for (int s = 0; s < KS; ++s) qf[s] = *(const bf16x8*)(Qrow + 16 * s + 8 * hh);
    if (!SB) {
#pragma unroll
        for (int j = 0; j < 8; ++j) {
            float sn, cs; rope_sc(qpos - PADF, 8 * hh + j, sn, cs);
            const float x1 = bf2f((bf16_t)qf[KS - 2][j]), x2 = bf2f((bf16_t)qf[KS - 1][j]);
            qf[KS - 2][j] = (short)f2bf(x1 * cs - x2 * sn); qf[KS - 1][j] = (short)f2bf(x1 * sn + x2 * cs);
        }
    }
    const bf16_t* Kbase = Kb + (size_t)(b * LP) * stride + h * HD;
    const bf16_t* VTb = VT + (size_t)(bh * 64) * LP;
    f32x16 O[2];
#pragma unroll
    for (int i = 0; i < 16; ++i) { O[0][i] = 0.f; O[1][i] = 0.f; }
    float mrun = -1e30f, lrun = 0.f, Lc = 0.f;
    for (int kb = qb32; kb >= 3; --kb) {
        const int kpos0 = kb * 32;
        bf16x8 kf[KS];
#pragma unroll
        for (int s = 0; s < KS; ++s) kf[s] = *(const bf16x8*)(Kbase + (size_t)(kpos0 + r) * stride + 16 * s + 8 * hh);
        bf16x8 vf[2][2];
#pragma unroll
        for (int mt = 0; mt < 2; ++mt)
#pragma unroll
            for (int s2 = 0; s2 < 2; ++s2) {
                const bf16_t* vp = VTb + (size_t)(mt * 32 + r) * LP + kpos0 + 16 * s2 + 4 * hh;
                const s16x4 lo = *(const s16x4*)vp, hi = *(const s16x4*)(vp + 8);
                vf[mt][s2] = __builtin_shufflevector(lo, hi, 0, 1, 2, 3, 4, 5, 6, 7);
            }
        f32x16 Sx;
#pragma unroll
        for (int i = 0; i < 16; ++i) Sx[i] = 0.f;
#pragma unroll
        for (int s = 0; s < KS; ++s) Sx = MFMA(kf[s], qf[s], Sx);
        const bool edge = (kb == qb32) || (kb == 3);
        float pv[16];
        if (!SB) {
            float zmax = -1e30f;
#pragma unroll
            for (int i = 0; i < 16; ++i) {
                float z = Sx[i] * scale;
                if (edge) { const int key = kpos0 + (i & 3) + 8 * (i >> 2) + 4 * hh; z = (key >= PADF && key <= qpos) ? z : -1e30f; }
                Sx[i] = z; zmax = fmaxf(zmax, z);
            }
            zmax = fmaxf(zmax, __shfl_xor(zmax, 32));
            const float mnew = fmaxf(mrun, zmax), alpha = __expf(mrun - mnew);
            float ps = 0.f;
#pragma unroll
            for (int i = 0; i < 16; ++i) { pv[i] = __expf(Sx[i] - mnew); ps += pv[i]; }
            lrun = lrun * alpha + ps; mrun = mnew;
#pragma unroll
            for (int i = 0; i < 16; ++i) { O[0][i] *= alpha; O[1][i] *= alpha; }
        } else {
            float lk[16], ls[16]; unsigned okm = 0;
#pragma unroll
            for (int i = 0; i < 16; ++i) {
                const float z = Sx[i] * scale, sp = softplusf_(z);
                bool ok = true;
                if (edge) { const int key = kpos0 + (i & 3) + 8 * (i >> 2) + 4 * hh; ok = (key >= PADF && key < qpos); }
                lk[i] = ok ? -sp : 0.f; ls[i] = z - sp; okm |= (ok ? 1u : 0u) << i;
            }
            float gs[4], pg[4];
#pragma unroll
            for (int q = 0; q < 4; ++q) { gs[q] = (lk[4 * q] + lk[4 * q + 1]) + (lk[4 * q + 2] + lk[4 * q + 3]); pg[q] = __shfl_xor(gs[q], 32); }
            float T[4]; float run = 0.f;
#pragma unroll
            for (int q = 3; q >= 0; --q) { T[q] = run + (hh == 0 ? pg[q] : 0.f); run += gs[q] + pg[q]; }
#pragma unroll
            for (int q = 0; q < 4; ++q) {
                float wsuf = 0.f;
#pragma unroll
                for (int e = 3; e >= 0; --e) {
                    const int i = 4 * q + e;
                    const float later = Lc + T[q] + wsuf;
                    pv[i] = ((okm >> i) & 1u) ? __expf(ls[i] + later) : 0.f;
                    wsuf += lk[i];
                }
            }
            Lc += run;
        }
        bf16x8 pb[2];
#pragma unroll
        for (int s2 = 0; s2 < 2; ++s2) {
            uint4 w; w.x = pack2(pv[8 * s2], pv[8 * s2 + 1]); w.y = pack2(pv[8 * s2 + 2], pv[8 * s2 + 3]); w.z = pack2(pv[8 * s2 + 4], pv[8 * s2 + 5]); w.w = pack2(pv[8 * s2 + 6], pv[8 * s2 + 7]);
            pb[s2] = __builtin_bit_cast(bf16x8, w);
        }
#pragma unroll
        for (int mt = 0; mt < 2; ++mt)
#pragma unroll
            for (int s2 = 0; s2 < 2; ++s2) O[mt] = MFMA(vf[mt][s2], pb[s2], O[mt]);
    }
    float inv = 1.0f;
    if (!SB) { const float lt = lrun + __shfl_xor(lrun, 32); inv = 1.0f / lt; }
    bf16_t* yrow = y + (size_t)(b * LP + qpos) * 1024 + ycol0 + h * 64;
#pragma unroll
    for (int mt = 0; mt < 2; ++mt)
#pragma unroll
        for (int g = 0; g < 4; ++g) {
            uint2 w; w.x = pack2(O[mt][4 * g] * inv, O[mt][4 * g + 1] * inv); w.y = pack2(O[mt][4 * g + 2] * inv, O[mt][4 * g + 3] * inv);
            *(uint2*)(yrow + mt * 32 + 8 * g + 4 * hh) = w;
        }
}

DI void rwkv_item(int item, char* S, float* lds) {
    const float* rwA = (const float*)(S + S_RWA); const bf16_t* rwB = (const bf16_t*)(S + S_RWB); float* raw = (float*)(S + S_RWRAW);
    const int bh = item >> 1, rg = item & 1, b = bh >> 2, h = bh & 3;
    const int tid = otid(), lane = tid & 63, wave = tid >> 6, part = lane & 15, rowl = wave * 4 + (lane >> 4);
    float* vecb = lds;
    float* vb = lds + 2 * 5120;
    const size_t Rb = (size_t)b * LP + PADF;
    auto gload = [&](int c, float4 (&st)[3], float& sv) {
#pragma unroll
        for (int i = 0; i < 3; ++i) {
            const int idx = tid + 512 * i, step = idx / 80, rem = idx % 80, vec = rem >> 4, c4 = rem & 15;
            const size_t R = Rb + c * 16 + step;
            if (idx >= 1280) {}
            else if (vec == 1) st[i] = *(const float4*)(rwA + R * 256 + h * 64 + c4 * 4);
            else {
                const int plane = vec == 0 ? 3 : (vec == 2 ? 4 : (vec == 3 ? 1 : 0));
                const uint2 raw2 = *(const uint2*)(rwB + R * 1280 + plane * 256 + h * 64 + c4 * 4);
                st[i] = make_float4(__uint_as_float(raw2.x << 16), __uint_as_float(raw2.x & 0xffff0000u), __uint_as_float(raw2.y << 16), __uint_as_float(raw2.y & 0xffff0000u));
            }
        }
        { const int step = tid >> 5, row = tid & 31; sv = bf2f(rwB[(Rb + c * 16 + step) * 1280 + 512 + h * 64 + rg * 32 + row]); }
    };
    auto lstore = [&](int buf, const float4 (&st)[3], float sv) {
#pragma unroll
        for (int i = 0; i < 3; ++i) {
            const int idx = tid + 512 * i, step = idx / 80, rem = idx % 80, vec = rem >> 4, c4 = rem & 15;
            if (idx < 1280) *(float4*)(vecb + buf * 5120 + step * 320 + vec * 64 + c4 * 4) = st[i];
        }
        vb[buf * 512 + tid] = sv;
    };
    float4 stA[3], stB[3]; float svA = 0.f, svB = 0.f;
#pragma unroll
    for (int i = 0; i < 3; ++i) { stA[i] = make_float4(0.f, 0.f, 0.f, 0.f); stB[i] = stA[i]; }
    gload(0, stA, svA); lstore(0, stA, svA);
    gload(1, stA, svA);
    __syncthreads();
    float4 Sx = make_float4(0.f, 0.f, 0.f, 0.f);
    constexpr int NC = LTOK / 16;
    for (int c = 0; c < NC; ++c) {
        const int cur = c & 1;
        if (c + 2 < NC) gload(c + 2, stB, svB);
        const float* vbp = vecb + cur * 5120 + part * 4;
        const float* vvp = vb + cur * 512 + rowl;
        float ykeep = 0.f;
#pragma unroll
        for (int s = 0; s < 16; ++s) {
            const float4 kk = *(const float4*)(vbp + s * 320), w = *(const float4*)(vbp + s * 320 + 64), kka = *(const float4*)(vbp + s * 320 + 128);
            const float4 k = *(const float4*)(vbp + s * 320 + 192), rr = *(const float4*)(vbp + s * 320 + 256);
            const float vv = vvp[s * 32];
            float sa = (Sx.x * kk.x + Sx.y * kk.y) + (Sx.z * kk.z + Sx.w * kk.w);
            sa = red16(sa);
            Sx.x = Sx.x * w.x + (vv * k.x - sa * kka.x);
            Sx.y = Sx.y * w.y + (vv * k.y - sa * kka.y);
            Sx.z = Sx.z * w.z + (vv * k.z - sa * kka.z);
            Sx.w = Sx.w * w.w + (vv * k.w - sa * kka.w);
            float yy = (Sx.x * rr.x + Sx.y * rr.y) + (Sx.z * rr.z + Sx.w * rr.w);
            yy = red16(yy);
            ykeep = (part == s) ? yy : ykeep;
        }
        raw[(Rb + c * 16 + part) * 256 + h * 64 + rg * 32 + rowl] = ykeep;
        if (c + 1 < NC) lstore(cur ^ 1, stA, svA);
        __syncthreads();
#pragma unroll
        for (int i = 0; i < 3; ++i) stA[i] = stB[i];
        svA = svB;
    }
}

DI void gla_item(int item, char* S, float* lds) {
    const float* glA = (const float*)(S + S_GLA); const bf16_t* Z = (const bf16_t*)(S + S_Z); float* raw = (float*)(S + S_GLRAW);
    const int bh = item >> 1, rg = item & 1, b = bh >> 2, h = bh & 3;
    const int tid = otid(), lane = tid & 63, wave = tid >> 6, part = lane & 15, rowl = wave * 4 + (lane >> 4);
    float* vecb = lds;
    float* vb = lds + 2 * 1536;
    const size_t Rb = (size_t)b * LP + PADF;
    auto gload = [&](int c, float4& st, float& sv) {
        if (tid < 384) {
            const int step = tid / 24, rem = tid % 24, vec = rem >> 3, c4 = rem & 7;
            const size_t R = Rb + c * 16 + step;
            if (vec == 0) st = *(const float4*)(glA + R * 128 + h * 32 + c4 * 4);
            else {
                const uint2 raw2 = *(const uint2*)(Z + R * ZLD + ZC_GLA + (vec == 1 ? 128 : 0) + h * 32 + c4 * 4);
                st = make_float4(__uint_as_float(raw2.x << 16), __uint_as_float(raw2.x & 0xffff0000u), __uint_as_float(raw2.y << 16), __uint_as_float(raw2.y & 0xffff0000u));
            }
        }
        { const int step = tid >> 5, row = tid & 31; sv = bf2f(Z[(Rb + c * 16 + step) * ZLD + ZC_GLA + 256 + h * 64 + rg * 32 + row]); }
    };
    auto lstore = [&](int buf, const float4& st, float sv) {
        if (tid < 384) { const int step = tid / 24, rem = tid % 24, vec = rem >> 3, c4 = rem & 7; *(float4*)(vecb + buf * 1536 + step * 96 + vec * 32 + c4 * 4) = st; }
        vb[buf * 512 + tid] = sv;
    };
    float4 stA = make_float4(0.f, 0.f, 0.f, 0.f), stB = stA; float svA = 0.f, svB = 0.f;
    gload(0, stA, svA); lstore(0, stA, svA);
    gload(1, stA, svA);
    __syncthreads();
    float s0 = 0.f, s1 = 0.f;
    constexpr int NC = LTOK / 16;
    for (int c = 0; c < NC; ++c) {
        const int cur = c & 1;
        if (c + 2 < NC) gload(c + 2, stB, svB);
        const float* vbp = vecb + cur * 1536 + part * 2;
        const float* vvp = vb + cur * 512 + rowl;
        float okeep = 0.f;
#pragma unroll
        for (int s = 0; s < 16; ++s) {
            const float2 a = *(const float2*)(vbp + s * 96), k = *(const float2*)(vbp + s * 96 + 32), q = *(const float2*)(vbp + s * 96 + 64);
            const float vv = vvp[s * 32];
            s0 = a.x * s0 + k.x * vv; s1 = a.y * s1 + k.y * vv;
            const float o = red16(q.x * s0 + q.y * s1);
            okeep = (part == s) ? o : okeep;
        }
        raw[(Rb + c * 16 + part) * 256 + h * 64 + rg * 32 + rowl] = okeep;
        if (c + 1 < NC) lstore(cur ^ 1, stA, svA);
        __syncthreads();
        stA = stB; svA = svB;
    }
}

__global__ void __launch_bounds__(NTHR, 2) mega(Params p) {
    cg::grid_group grid = cg::this_grid();
    extern __shared__ __attribute__((aligned(16))) unsigned char dynlds[];
    __shared__ __attribute__((aligned(16))) unsigned s_misc[4];
    PG8_LAS unsigned char* ldsL = (PG8_LAS unsigned char*)dynlds;
    float* ldsf = (float*)dynlds;
    char* ws = p.ws;
    unsigned* ctr = (unsigned*)(ws + OFF_CTR);
    float* h = (float*)(ws + OFF_H); bf16_t* nb = (bf16_t*)(ws + OFF_NB); bf16_t* y = (bf16_t*)(ws + OFF_Y);
    char* Wb = ws + OFF_W; char* S = ws + OFF_S;
    bf16_t* winT = (bf16_t*)(Wb + W_WIN); bf16_t* uqT = (bf16_t*)(Wb + W_UQ); bf16_t* ukvT = (bf16_t*)(Wb + W_UKV); bf16_t* brT = (bf16_t*)(Wb + W_BR);
    bf16_t* woutT = (bf16_t*)(Wb + W_OUT); bf16_t* finT = (bf16_t*)(Wb + W_FIN); bf16_t* foutT = (bf16_t*)(Wb + W_FOUT);
    bf16_t* Z = (bf16_t*)(S + S_Z); bf16_t* cqn = (bf16_t*)(S + S_CQN); bf16_t* ckvn = (bf16_t*)(S + S_CKVN); bf16_t* Qm = (bf16_t*)(S + S_QM); bf16_t* Km = (bf16_t*)(S + S_KM);
    bf16_t* VTm = (bf16_t*)(S + S_VTM); bf16_t* VTs = (bf16_t*)(S + S_VTS); bf16_t* merged = (bf16_t*)(S + S_MERGED); bf16_t* gates = (bf16_t*)(S + S_GATES);
    bf16_t* au = (bf16_t*)(S + S_AU); bf16_t* act = (bf16_t*)(S + S_ACT);
    const int gthreads = gridDim.x * NTHR, G = gridDim.x;
    if (threadIdx.x < 4) s_misc[threadIdx.x] = 0u;
    __syncthreads();
    XcdBarrier xbar = xcd_barrier_post((unsigned*)(ws + OFF_BAR), (volatile PG8_LAS unsigned*)s_misc);
    bool first_sync = true;

    for (int layer = 0; layer < 4; ++layer) {
        LayerW L;
        L.q_norm = p.in[4] + layer * 256; L.kv_norm = p.in[6] + layer * 128; L.mu = p.in[8] + layer * 1024; L.w0 = p.in[9] + layer * 256;
        L.w2 = p.in[10] + layer * 64 * 256; L.a0 = p.in[11] + layer * 256; L.a2 = p.in[12] + layer * 64 * 256; L.g2 = p.in[13] + layer * 128 * 256;
        L.k_k = p.in[14] + layer * 256; L.k_a = p.in[15] + layer * 256; L.r_k = p.in[16] + layer * 256; L.ln_w = p.in[17] + layer * 256; L.ln_b = p.in[18] + layer * 256;
        L.gla_a2 = p.in[19] + layer * 16 * 128; L.gla_a_b = p.in[20] + layer * 128; L.gla_norm = p.in[21] + layer * 256; L.gate_b = p.in[22] + layer * 4096;
        L.conv_w = p.in[27] + layer * 3 * DFF; L.conv_b = p.in[28] + layer * DFF;

        REP(0) PH(0) { const int gtid = obid() * NTHR + otid();
            convT(p.in[3] + (size_t)layer * 1024 * INTOT, 1024, INTOT, winT, gtid, gthreads);
            convT(p.in[5] + (size_t)layer * 256 * 384, 256, 384, uqT, gtid, gthreads);
            convT(p.in[7] + (size_t)layer * 128 * 512, 128, 512, ukvT, gtid, gthreads);
            for (int n = 0; n < 4; ++n) convT(p.in[23] + ((size_t)layer * 4 + n) * 256 * 1024, 256, 1024, brT + (size_t)n * 1024 * 256, gtid, gthreads);
            convT(p.in[24] + (size_t)layer * 1024 * 1024, 1024, 1024, woutT, gtid, gthreads);
            convT(p.in[26] + (size_t)layer * 1024 * 5632, 1024, 5632, finT, gtid, gthreads);
            convT(p.in[29] + (size_t)layer * DFF * 1024, DFF, 1024, foutT, gtid, gthreads);
            phase_norm(layer == 0 ? 1 : 0, p, h, p.in[2] + layer * 1024, nb);
        }
        GSYNC();

        REP(1) PH(1) { pg8::Gemm g{nb, winT, M, ZLD, 1024}; pg8::StaticOrder So; So.init(M, ZLD, G, obid()); pg8::EpiStoreBf16 E{Z, ZLD};
            pg8::gemm_phase<pg8::EpiStoreBf16, pg8::StaticOrder, true, true>(ldsL, g, So, E); }
        GSYNC();

        REP(2) PH(2) phase_prep(L, S, ldsf);
        GSYNC();

        REP(3) PH(3) phase_gemm_small<2>(cqn, 256, uqT, 256, M, 384, 256, dynlds,
                      [&](int row, int col, float v) { Qm[(size_t)row * 384 + col] = f2bf(v); });
        REP(3) PH(4) phase_gemm_small<2>(ckvn, 128, ukvT, 128, M, 512, 128, dynlds,
                      [&](int row, int col, float v) {
                          const int hd = col >> 7, c = col & 127;
                          if (c < 64) Km[(size_t)row * 384 + hd * 96 + c] = f2bf(v);
                          else { const int b = row / LP, pos = row % LP; VTm[((size_t)((b * 4 + hd) * 64 + (c - 64))) * LP + pos] = f2bf(v); }
                      });
        GSYNC();

        REP(4) for (;;) {
            const int tid = otid();
            if (tid == 0) s_misc[2] = atomicAdd(ctr + layer * 2 + rep_, 1u);
            __syncthreads();
            const int item = (int)s_misc[2];
            __syncthreads();
            if (item >= 64 + 17 * 32) break;
            if (item < 32) { PH(5) if (rep_ == 0 || (REP2SEL & 1)) rwkv_item(item, S, ldsf); }
            else if (item < 64) { PH(6) if (rep_ == 0 || (REP2SEL & 2)) gla_item(item - 32, S, ldsf); }
            else {
                const int a = item - 64, qblk = 16 - a / 32, rem = a % 32, bh = rem & 15;
                if (rem < 16) { PH(7) if (rep_ == 0 || (REP2SEL & 4)) attn_item<false>(bh, qblk, Qm, Km, 384, VTm, y, 0); }
                else { PH(8) if (rep_ == 0 || (REP2SEL & 8)) attn_item<true>(bh, qblk, Z + ZC_SB, Z + ZC_SB + 256, ZLD, VTs, y, 512); }
            }
        }
        GSYNC();

        REP(5) PH(9) {
            const float* rwRaw = (const float*)(S + S_RWRAW); const float* glRaw = (const float*)(S + S_GLRAW);
            const bf16_t* rwB = (const bf16_t*)(S + S_RWB); const bf16_t* rwG = (const bf16_t*)(S + S_RWG); const float* rwBon = (const float*)(S + S_RWBON);
            const int tid0 = otid(), half = tid0 >> 8, tid = tid0 & 255;
            const float lnw = L.ln_w[tid], lnb = L.ln_b[tid], gn = L.gla_norm[tid];
            for (int R = obid() * 2 + half; R < M; R += 2 * G) {
                if (R % LP < PADF) continue;
                {
                    const float yv = rwRaw[(size_t)R * 256 + tid];
                    const float mean = wsum(yv) * (1.0f / 64.0f), d = yv - mean;
                    const float var = wsum(d * d) * (1.0f / 64.0f);
                    float yn = d * rsqrtf(var + 64e-5f) * lnw + lnb;
                    yn += rwBon[(size_t)R * 4 + (tid >> 6)] * bf2f(rwB[(size_t)R * 1280 + 512 + tid]);
                    y[(size_t)R * 1024 + 256 + tid] = f2bf(yn * bf2f(rwG[(size_t)R * 256 + tid]));
                }
                {
                    const float o = glRaw[(size_t)R * 256 + tid] * 0.17677669529663687f;
                    const float ms = wsum(o * o) * (1.0f / 64.0f);
                    const float on = o * rsqrtf(ms + 1e-6f) * gn;
                    const float rgv = bf2f(Z[(size_t)R * ZLD + ZC_GLA + 528 + tid]);
                    y[(size_t)R * 1024 + 768 + tid] = f2bf(on * rgv * sigmoidf_(rgv));
                }
            }
        }
        GSYNC();

        REP(6) PH(10) { pg8::Gemm g{nb, winT + (size_t)GATE0 * 1024, M, 4096, 1024}; pg8::StaticOrder So; So.init(M, 4096, G, obid()); pg8::EpiGate E{gates, 4096, L.gate_b};
            pg8::gemm_phase<pg8::EpiGate, pg8::StaticOrder, true, true>(ldsL, g, So, E); }
        GSYNC();

        REP(7) PH(11) {
            const int tid0 = otid(), half = tid0 >> 8, vt = tid0 & 255, bid = obid();
            bf16_t* lds = (bf16_t*)(dynlds + half * 40960);
            constexpr int nT = (M / 128) * 16;
            const int iters = (nT + 2 * G - 1) / (2 * G);
            for (int it = 0; it < iters; ++it) {
                int t = (it * G + bid) * 2 + half; const bool active = t < nT; if (!active) t = nT - 1;
                const int mt = t >> 4, nt = t & 15, m0 = mt * 128, n0 = nt * 64;
                f32x16 out[2][1]; acc_zero<1>(out);
                const int lane = vt & 63, wave = vt >> 6, wm = wave >> 1, wn = wave & 1, r = lane & 31, hh = lane >> 5;
                for (int n = 0; n < 4; ++n) {
                    f32x16 ab[2][1]; acc_zero<1>(ab);
                    gemm_tile<1>(ab, y + (size_t)m0 * 1024 + n * 256, 1024, brT + (size_t)(n * 1024 + n0) * 256, 256, 256, lds, vt);
                    const bf16_t* gp = gates + (size_t)(m0 + wm * 64 + 4 * hh) * 4096 + n * 1024 + n0 + wn * 32 + r;
#pragma unroll
                    for (int a = 0; a < 2; ++a)
#pragma unroll
                        for (int i = 0; i < 16; ++i) out[a][0][i] += bf2f(gp[(size_t)(a * 32 + (i & 3) + 8 * (i >> 2)) * 4096]) * ab[a][0][i];
                }
                if (active) epi_foreach<1>(out, m0, n0, vt, [&](int row, int col, float v) { merged[(size_t)row * 1024 + col] = f2bf(v); });
            }
        }
        GSYNC();

        REP(11) PH(12) { pg8::Gemm g{merged, woutT, M, 1024, 1024}; pg8::StaticOrder So; So.init(M, 1024, G, obid()); pg8::EpiResid E{h, 0, (((REPMASK >> 11) & 1u) && rep_ == 0) ? 0.f : 1.f};
            pg8::gemm_phase<pg8::EpiResid, pg8::StaticOrder, true, true>(ldsL, g, So, E); }
        GSYNC();

        REP(8) PH(13) phase_norm(0, p, h, p.in[25] + layer * 1024, nb);
        GSYNC();

        for (int hf = 0; hf < 2; ++hf) {
            REP(9) PH(14) { pg8::Gemm g{nb + (size_t)hf * MH * 1024, finT, MH, 5632, 1024}; pg8::StaticOrder So; So.init(MH, 5632, G, obid()); pg8::EpiStoreBf16 E{au, 5632};
                pg8::gemm_phase<pg8::EpiStoreBf16, pg8::StaticOrder, true, true>(ldsL, g, So, E); }
            GSYNC();
            REP(10) PH(15) {
                const long total = (long)MH * (DFF / 4); const int gtid = obid() * NTHR + otid();
                for (long u = gtid; u < total; u += gthreads) {
                    const int rl = (int)(u / (DFF / 4)), f = (int)(u % (DFF / 4)) * 4;
                    const int tok = (hf * MH + rl) % LP - PADF;
                    const bf16_t* a2p = au + (size_t)rl * 5632 + f;
                    float out4[4];
                    const float4 cb = *(const float4*)(L.conv_b + f), w0 = *(const float4*)(L.conv_w + f), w1 = *(const float4*)(L.conv_w + DFF + f), w2 = *(const float4*)(L.conv_w + 2 * DFF + f);
                    const float cbv[4] = {cb.x, cb.y, cb.z, cb.w}, w0v[4] = {w0.x, w0.y, w0.z, w0.w}, w1v[4] = {w1.x, w1.y, w1.z, w1.w}, w2v[4] = {w2.x, w2.y, w2.z, w2.w};
                    const uint2 c0 = *(const uint2*)a2p, uu = *(const uint2*)(a2p + DFF);
                    uint2 c1 = make_uint2(0u, 0u), c2 = make_uint2(0u, 0u);
                    if (tok >= 1) c1 = *(const uint2*)(a2p - 5632);
                    if (tok >= 2) c2 = *(const uint2*)(a2p - 2 * 5632);
                    const float a0v[4] = {__uint_as_float(c0.x << 16), __uint_as_float(c0.x & 0xffff0000u), __uint_as_float(c0.y << 16), __uint_as_float(c0.y & 0xffff0000u)};
                    const float a1v[4] = {__uint_as_float(c1.x << 16), __uint_as_float(c1.x & 0xffff0000u), __uint_as_float(c1.y << 16), __uint_as_float(c1.y & 0xffff0000u)};
                    const float a2v[4] = {__uint_as_float(c2.x << 16), __uint_as_float(c2.x & 0xffff0000u), __uint_as_float(c2.y << 16), __uint_as_float(c2.y & 0xffff0000u)};
                    const float uv[4] = {__uint_as_float(uu.x << 16), __uint_as_float(uu.x & 0xffff0000u), __uint_as_float(uu.y << 16), __uint_as_float(uu.y & 0xffff0000u)};
#pragma unroll
                    for (int e = 0; e < 4; ++e) { const float a = cbv[e] + w0v[e] * a2v[e] + w1v[e] * a1v[e] + w2v[e] * a0v[e]; out4[e] = a * sigmoidf_(a) * uv[e]; }
                    uint2 w; w.x = pack2(out4[0], out4[1]); w.y = pack2(out4[2], out4[3]);
                    *(uint2*)(act + (size_t)rl * DFF + f) = w;
                }
            }
            GSYNC();
            REP(12) PH(16) { pg8::Gemm g{act, foutT, MH, 1024, DFF}; pg8::StaticOrder So; So.init(MH, 1024, G, obid()); pg8::EpiResid E{h, hf * MH, (((REPMASK >> 12) & 1u) && rep_ == 0) ? 0.f : 1.f};
                pg8::gemm_phase<pg8::EpiResid, pg8::StaticOrder, true, true>(ldsL, g, So, E); }
            GSYNC();
        }
    }
    PH(17) phase_norm(2, p, h, p.in[30], nb);
}

extern "C" void kernel_launch(void* const* d_in, const int* in_sizes, int n_in, void* d_out, int out_size, void* d_ws, size_t ws_size, hipStream_t stream) {
    static int grid_blocks = 0;
    if (!grid_blocks) {
        int dev = 0, cus = 0, per_cu = 0;
        (void)hipGetDevice(&dev);
        (void)hipDeviceGetAttribute(&cus, hipDeviceAttributeMultiprocessorCount, dev);
        if (hipFuncSetAttribute((const void*)mega, hipFuncAttributeMaxDynamicSharedMemorySize, DYN_LDS) != hipSuccess) fprintf(stderr, "hipFuncSetAttribute failed\n");
        (void)hipOccupancyMaxActiveBlocksPerMultiprocessor(&per_cu, mega, NTHR, DYN_LDS);
        if (per_cu != 1) fprintf(stderr, "note: occupancy query says %d blocks per CU; launching one per CU\n", per_cu);
        (void)hipGetLastError();
        grid_blocks = cus;
    }
    if (ws_size < WS_NEED) fprintf(stderr, "workspace too small: %zu < %zu\n", ws_size, (size_t)WS_NEED);
    Params p{};
    for (int i = 0; i < 31; ++i) p.in[i] = (const float*)d_in[i];
    p.out = (float*)d_out; p.ws = (char*)d_ws;
    (void)hipMemsetAsync(d_ws, 0, 16384, stream);
    void* args[] = {&p};
    hipError_t e = hipLaunchCooperativeKernel((void*)mega, dim3(grid_blocks), dim3(NTHR), args, DYN_LDS, stream);
    if (e != hipSuccess) fprintf(stderr, "cooperative launch failed: %s (grid %d)\n", hipGetErrorString(e), grid_blocks);
}
```
